# Optimizing an MI355X kernel written in HIP

```python
import math
import jax, jax.numpy as jnp
from jax import lax
import numpy as np

D_MODEL = 1024
BATCH = 8
SEQ = 2048
DEPTH = 1
DEC_BATCH = 128
DEC_SEQ = 4
PAST_LEN = 2048
PAGE_SIZE = 128

R_HEADS = 8
R_HEAD_DIM = 64
R_WIDTH = R_HEADS * R_HEAD_DIM
DECAY_LORA = 64
AAA_LORA = 64
GATE_LORA = 128
R_COLS = 3 * R_WIDTH + DECAY_LORA + AAA_LORA + GATE_LORA
A_HEADS = 4
A_QK_DIM = 64
A_V_DIM = 2 * A_QK_DIM
A_WIDTH = A_HEADS * A_V_DIM
A_COLS = A_HEADS * (2 * 2 * A_QK_DIM + A_V_DIM)
MIX_WIDTH = R_WIDTH + A_WIDTH
PROJ_COLS = A_COLS + R_COLS
D_FF = 2816
NUM_BUCKETS = 32
MAX_DISTANCE = 128
Q_BLOCK = 128
NORM_EPS = 1e-6
SUBLN_EPS = 1e-5
GN_EPS = 64e-5
N_SUBNORMS = 6
NEG_INF = -1e30

kernel_name = 'hybrid_rwkv7_diffattn_macaron_step'


def rms_norm(x, g, eps):
    xf = x.astype(jnp.float32)
    y = xf * lax.rsqrt(jnp.mean(xf * xf, axis=-1, keepdims=True) + eps)
    return (y * g.astype(jnp.float32)).astype(x.dtype)


def swiglu(x, w_in, w_out):
    gate, up = jnp.split(x @ w_in, 2, axis=-1)
    return (jax.nn.silu(gate) * up) @ w_out


def rel_bias(q_pos, k_pos, table):
    n = jnp.maximum(q_pos[:, None] - k_pos[None, :], 0)
    max_exact = NUM_BUCKETS // 2
    large = max_exact + (jnp.log(jnp.maximum(n, 1).astype(jnp.float32) / max_exact)
                         / math.log(MAX_DISTANCE / max_exact)
                         * (NUM_BUCKETS - max_exact)).astype(jnp.int32)
    large = jnp.minimum(large, NUM_BUCKETS - 1)
    bucket = jnp.where(n < max_exact, n, large)
    return jnp.transpose(table[bucket], (2, 0, 1)).astype(jnp.float32)


def diff_attend(q, k, v, q_pos, k_pos, table, lam):
    bias = rel_bias(q_pos, k_pos, table)
    s = jnp.einsum('bqhmd,bkhmd->bhmqk', q, k).astype(jnp.float32) * (A_QK_DIM ** -0.5)
    s = s + bias[None, :, None]
    s = jnp.where(k_pos[None, :] <= q_pos[:, None], s, NEG_INF)
    p = jax.nn.softmax(s, axis=-1)
    p = p[:, :, 0] - lam * p[:, :, 1]
    return jnp.einsum('bhqk,bkhd->bqhd', p.astype(v.dtype), v)


def diff_attend_blocked(q, k, v, table, lam):
    B, T = q.shape[0], q.shape[1]
    nb = T // Q_BLOCK
    qb = jnp.moveaxis(q.reshape(B, nb, Q_BLOCK, A_HEADS, 2, A_QK_DIM), 1, 0)
    k_pos = jnp.arange(T)
    starts = jnp.arange(nb) * Q_BLOCK

    def one(args):
        q_blk, s0 = args
        return diff_attend(q_blk, k, v, s0 + jnp.arange(Q_BLOCK), k_pos, table, lam)

    out = lax.map(one, (qb, starts))
    return jnp.moveaxis(out, 0, 1).reshape(B, T, A_HEADS, A_V_DIM)


def gather_pages(pool, page_table):
    g = pool[page_table]
    return g.reshape((page_table.shape[0], page_table.shape[1] * pool.shape[1]) + pool.shape[2:])


def wkv_scan(r, w, k, v, kk, a, s0):
    def step(S, inp):
        r_t, w_t, k_t, v_t, kk_t, a_t = inp
        sa = jnp.einsum('bhvk,bhk->bhv', S, -kk_t)
        S = (S * w_t[:, :, None, :] + sa[..., None] * (kk_t * a_t)[:, :, None, :]
             + v_t[..., None] * k_t[:, :, None, :])
        return S, jnp.einsum('bhvk,bhk->bhv', S, r_t)

    xs = tuple(jnp.moveaxis(t, 1, 0) for t in (r, w, k, v, kk, a))
    S, ys = lax.scan(step, s0.astype(jnp.float32), xs)
    return jnp.moveaxis(ys, 0, 1), S


def mixer(h, l, shift0, wkv0, attend, P):
    f32 = jnp.float32
    B, T = h.shape[0], h.shape[1]
    p = h @ P['w_in'][l]
    QK = A_HEADS * 2 * A_QK_DIM
    q = p[..., :QK].reshape(B, T, A_HEADS, 2, A_QK_DIM)
    k = p[..., QK:2 * QK].reshape(B, T, A_HEADS, 2, A_QK_DIM)
    v = p[..., 2 * QK:A_COLS].reshape(B, T, A_HEADS, A_V_DIM)
    lam_init = 0.8 - 0.6 * math.exp(-0.3 * l)
    lam = (jnp.exp(jnp.sum(P['da_lq1'][l].astype(f32) * P['da_lk1'][l].astype(f32)))
           - jnp.exp(jnp.sum(P['da_lq2'][l].astype(f32) * P['da_lk2'][l].astype(f32)))
           + lam_init)
    o = attend(q, k, v, lam)
    o_attn = (rms_norm(o, P['da_subln'][l], SUBLN_EPS) * (1.0 - lam_init)).reshape(B, T, A_WIDTH)
    pr = p[..., A_COLS:]
    prev = jnp.concatenate([shift0[:, None, :].astype(pr.dtype), pr[:, :-1]], axis=1)
    xr = pr + (prev - pr) * P['rw_mu'][l]
    r, kr, vr, w_lo, a_lo, g_lo = jnp.split(
        xr, [R_WIDTH, 2 * R_WIDTH, 3 * R_WIDTH, 3 * R_WIDTH + DECAY_LORA,
             3 * R_WIDTH + DECAY_LORA + AAA_LORA], axis=-1)
    log_w = -jax.nn.softplus(-(P['rw_w0'][l] + jnp.tanh(w_lo) @ P['rw_w2'][l])) - 0.5
    decay = jnp.exp(-jnp.exp(log_w.astype(f32)))
    a = jax.nn.sigmoid(P['rw_a0'][l] + a_lo @ P['rw_a2'][l])
    g = jax.nn.sigmoid(g_lo) @ P['rw_g2'][l]

    def heads(t):
        return t.reshape(B, T, R_HEADS, R_HEAD_DIM).astype(f32)

    kk = heads(kr * P['rw_kk'][l])
    kk = kk / jnp.maximum(jnp.sqrt(jnp.sum(kk * kk, axis=-1, keepdims=True)), 1e-12)
    kr = kr * (1.0 + (a - 1.0) * P['rw_ka'][l])
    rh, kh, vh, ah = heads(r), heads(kr), heads(vr), heads(a)
    y, wkv_new = wkv_scan(rh, heads(decay), kh, vh, kk, ah, wkv0)
    mu = jnp.mean(y, axis=-1, keepdims=True)
    var = jnp.mean(jnp.square(y - mu), axis=-1, keepdims=True)
    yn = ((y - mu) * lax.rsqrt(var + GN_EPS)).reshape(B, T, R_WIDTH)
    yn = yn * P['rw_gn_w'][l].astype(f32) + P['rw_gn_b'][l].astype(f32)
    bonus = jnp.sum(rh * kh * P['rw_rk'][l].astype(f32), axis=-1, keepdims=True) * vh
    o_rwkv = ((yn + bonus.reshape(B, T, R_WIDTH)) * g.astype(f32)).astype(h.dtype)
    out = jnp.concatenate([o_rwkv, o_attn.astype(h.dtype)], axis=-1) @ P['w_out'][l]
    return out, k, v, wkv_new, pr[:, -1]


def layer(x, l, shift0, wkv0, attend, P):
    g = P['norm_gains'][l]
    h = x + 0.5 * rms_norm(swiglu(rms_norm(x, g[0], NORM_EPS), P['ff1_in'][l], P['ff1_out'][l]), g[1], NORM_EPS)
    m, k, v, wkv, shift = mixer(rms_norm(h, g[2], NORM_EPS), l, shift0, wkv0, attend, P)
    h = h + rms_norm(m, g[3], NORM_EPS)
    h = h + 0.5 * rms_norm(swiglu(rms_norm(h, g[4], NORM_EPS), P['ff2_in'][l], P['ff2_out'][l]), g[5], NORM_EPS)
    return h, k, v, wkv, shift


def setup_inputs(seed: int = 0) -> dict:
    key = jax.random.key(seed)
    ks = iter(jax.random.split(key, 40))
    n_pages = PAST_LEN // PAGE_SIZE
    used = DEC_BATCH * n_pages
    n_pool = used + max(1, used // 4)

    def nrm(shape, scale):
        return jax.random.normal(next(ks), shape, jnp.float32) * scale

    inp = {}
    inp['x_prompt'] = nrm((BATCH, SEQ, D_MODEL), 1.0)
    inp['x_sample'] = nrm((DEC_BATCH, DEC_SEQ, D_MODEL), 1.0)
    inp['cache_k'] = nrm((DEPTH, n_pool, PAGE_SIZE, A_HEADS, 2, A_QK_DIM), 1.0)
    inp['cache_v'] = nrm((DEPTH, n_pool, PAGE_SIZE, A_HEADS, A_V_DIM), 1.0)
    inp['page_table'] = jax.random.permutation(next(ks), n_pool)[:used].reshape(DEC_BATCH, n_pages).astype(jnp.int32)
    inp['state_wkv'] = nrm((DEPTH, DEC_BATCH, R_HEADS, R_HEAD_DIM, R_HEAD_DIM), 0.3)
    inp['state_shift'] = nrm((DEPTH, DEC_BATCH, R_COLS), 1.0)
    inp['norm_gains'] = 1.0 + nrm((DEPTH, N_SUBNORMS, D_MODEL), 0.05)
    inp['ff1_in'] = nrm((DEPTH, D_MODEL, 2 * D_FF), D_MODEL ** -0.5)
    inp['ff1_out'] = nrm((DEPTH, D_FF, D_MODEL), D_FF ** -0.5)
    inp['ff2_in'] = nrm((DEPTH, D_MODEL, 2 * D_FF), D_MODEL ** -0.5)
    inp['ff2_out'] = nrm((DEPTH, D_FF, D_MODEL), D_FF ** -0.5)
    inp['w_in'] = nrm((DEPTH, D_MODEL, PROJ_COLS), D_MODEL ** -0.5)
    inp['w_out'] = nrm((DEPTH, MIX_WIDTH, D_MODEL), MIX_WIDTH ** -0.5)
    inp['rel_bias_table'] = nrm((NUM_BUCKETS, A_HEADS), 0.3)
    inp['da_lq1'] = nrm((DEPTH, A_QK_DIM), 0.1)
    inp['da_lk1'] = nrm((DEPTH, A_QK_DIM), 0.1)
    inp['da_lq2'] = nrm((DEPTH, A_QK_DIM), 0.1)
    inp['da_lk2'] = nrm((DEPTH, A_QK_DIM), 0.1)
    inp['da_subln'] = 1.0 + nrm((DEPTH, A_V_DIM), 0.05)
    inp['rw_mu'] = jax.random.uniform(next(ks), (DEPTH, R_COLS), jnp.float32)
    inp['rw_w0'] = nrm((DEPTH, R_WIDTH), 0.5) - 0.5
    inp['rw_w2'] = nrm((DEPTH, DECAY_LORA, R_WIDTH), 0.5 * DECAY_LORA ** -0.5)
    inp['rw_a0'] = nrm((DEPTH, R_WIDTH), 0.1)
    inp['rw_a2'] = nrm((DEPTH, AAA_LORA, R_WIDTH), 0.5 * AAA_LORA ** -0.5)
    inp['rw_g2'] = nrm((DEPTH, GATE_LORA, R_WIDTH), GATE_LORA ** -0.5)
    inp['rw_kk'] = 0.85 + nrm((DEPTH, R_WIDTH), 0.05)
    inp['rw_ka'] = 1.0 + nrm((DEPTH, R_WIDTH), 0.05)
    inp['rw_rk'] = nrm((DEPTH, R_HEADS, R_HEAD_DIM), 0.1)
    inp['rw_gn_w'] = 1.0 + nrm((DEPTH, R_WIDTH), 0.05)
    inp['rw_gn_b'] = nrm((DEPTH, R_WIDTH), 0.01)
    return inp


def reference(x_prompt, x_sample, cache_k, cache_v, page_table, state_wkv, state_shift,
              norm_gains, ff1_in, ff1_out, ff2_in, ff2_out, w_in, w_out, rel_bias_table,
              da_lq1, da_lk1, da_lq2, da_lk2, da_subln, rw_mu, rw_w0, rw_w2, rw_a0, rw_a2,
              rw_g2, rw_kk, rw_ka, rw_rk, rw_gn_w, rw_gn_b):
    P = {'norm_gains': norm_gains, 'ff1_in': ff1_in, 'ff1_out': ff1_out,
         'ff2_in': ff2_in, 'ff2_out': ff2_out, 'w_in': w_in, 'w_out': w_out,
         'da_lq1': da_lq1, 'da_lk1': da_lk1, 'da_lq2': da_lq2, 'da_lk2': da_lk2,
         'da_subln': da_subln, 'rw_mu': rw_mu, 'rw_w0': rw_w0, 'rw_w2': rw_w2,
         'rw_a0': rw_a0, 'rw_a2': rw_a2, 'rw_g2': rw_g2, 'rw_kk': rw_kk,
         'rw_ka': rw_ka, 'rw_rk': rw_rk, 'rw_gn_w': rw_gn_w, 'rw_gn_b': rw_gn_b}
    B = x_prompt.shape[0]
    hp, hs = x_prompt, x_sample
    kps, vps, kss, vss, wps, wss, sps, sss = [], [], [], [], [], [], [], []

    def attend_p(q, k, v, lam):
        return diff_attend_blocked(q, k, v, rel_bias_table, lam)

    for l in range(DEPTH):
        past_k = gather_pages(cache_k[l], page_table)
        past_v = gather_pages(cache_v[l], page_table)

        def attend_s(q, k, v, lam, past_k=past_k, past_v=past_v):
            tp, tn = past_k.shape[1], q.shape[1]
            kf = jnp.concatenate([past_k.astype(k.dtype), k], axis=1)
            vf = jnp.concatenate([past_v.astype(v.dtype), v], axis=1)
            return diff_attend(q, kf, vf, tp + jnp.arange(tn), jnp.arange(tp + tn),
                               rel_bias_table, lam)

        hp, kp, vp, wp, sp = layer(hp, l, jnp.zeros((B, R_COLS), x_prompt.dtype),
                                   jnp.zeros((B, R_HEADS, R_HEAD_DIM, R_HEAD_DIM), jnp.float32),
                                   attend_p, P)
        hs, ks_, vs_, ws_, ss_ = layer(hs, l, state_shift[l], state_wkv[l], attend_s, P)
        kps.append(kp); vps.append(vp); wps.append(wp); sps.append(sp)
        kss.append(ks_); vss.append(vs_); wss.append(ws_); sss.append(ss_)

    return (hp, hs, jnp.stack(kps), jnp.stack(vps), jnp.stack(kss), jnp.stack(vss),
            jnp.stack(wps), jnp.stack(wss), jnp.stack(sps), jnp.stack(sss))
```

```cpp
#include <hip/hip_runtime.h>
#include <cstdio>
#include <cstdint>
#ifndef MK_PER_PHASE
#define MK_PER_PHASE 0
#endif
namespace pg8 {
#define PG8_LAS __attribute__((address_space(3)))
typedef unsigned short bf16_t;
typedef short bf16x8 __attribute__((ext_vector_type(8)));
typedef float f32x4 __attribute__((ext_vector_type(4)));
typedef unsigned u32x4 __attribute__((ext_vector_type(4)));
constexpr int BM = 256, BK = 64, HALF = 128, HTB = HALF * BK * 2  , STAGE_BYTES = 8 * HTB, NXCD = 8, WGM = 8;

__host__ __device__ __forceinline__ int lds_byte(int r, int c) { const int st = (r >> 4) * 2 + (c >> 5), rr = r & 15, cc = c & 31, ob = rr * 64 + cc * 2; return st * 1024 + (ob ^ (((ob >> 9) & 1) << 5)); }
__host__ __device__ __forceinline__ void stage_rc(int b, int& R, int& C) { const int st = b / 1024, sb = b % 1024, swz = sb ^ (((sb >> 9) & 1) << 5); R = (st >> 1) * 16 + swz / 64; C = (st & 1) * 32 + (swz % 64) / 2; }
__host__ __device__ __forceinline__ int perm32(int rho) { const int n = rho >> 4, i = rho & 15; return 8 * (i >> 2) + 4 * n + (i & 3); }

struct Unit { int pm, pn; };
struct Gemm { const bf16_t* A; const bf16_t* Bt; int M, N, K; };

struct StaticOrder {
    int nM, nN, nwg, G, c;
    __host__ __device__ void init(int M, int N, int G_, int c_) { nM = M / BM; nN = N / BM; nwg = nM * nN; G = G_; c = c_; }
    __host__ __device__ bool next(int i, Unit& u) const {
        const long L = (long)i * G + c; if (L >= nwg) return false;
        int wgid = (int)L; { const int q = nwg / NXCD, r = nwg % NXCD, xcd = wgid % NXCD, off = wgid / NXCD; wgid = (xcd < r ? xcd * (q + 1) : r * (q + 1) + (xcd - r) * q) + off; }
        const int nig = WGM * nN, gid = wgid / nig, fm = gid * WGM, gsz = (nM - fm) < WGM ? (nM - fm) : WGM;
        u.pm = fm + ((wgid % nig) % gsz); u.pn = (wgid % nig) / gsz; return true;
    }
    __device__ __forceinline__ void a_ready(const Unit&) const {}
    __device__ __forceinline__ void done(const Unit&) const {}
};

__device__ __forceinline__ unsigned cvt_pk_bf16(float lo, float hi) { unsigned r; asm volatile("v_cvt_pk_bf16_f32 %0, %1, %2" : "=v"(r) : "v"(lo), "v"(hi)); return r; }
typedef float f32x2 __attribute__((ext_vector_type(2)));
__device__ __forceinline__ f32x2 gelu_pk(f32x2 v) {
    const f32x2 av = __builtin_elementwise_abs(v), d = av * 0.2316418882f + 1.0f;
    f32x2 t; t.x = __builtin_amdgcn_rcpf(d.x); t.y = __builtin_amdgcn_rcpf(d.y);
    f32x2 q = t * 0.5307027145f + (-0.7265760135f); q = q * t + 0.7107068705f; q = q * t + (-0.142248368f); q = q * t + 0.127414796f; q = q * t;
    const f32x2 s = (v * v) * (-0.72134752044f);
    f32x2 e; e.x = __builtin_amdgcn_exp2f(s.x); e.y = __builtin_amdgcn_exp2f(s.y);
    const f32x2 m = v * (q * e), r = v - m;
    f32x2 o; o.x = v.x < 0.f ? m.x : r.x; o.y = v.y < 0.f ? m.y : r.y; return o;
}

template <int ACT  > struct EpiBf16 {
    static constexpr bool PERM = true, AFTER_DRAIN = false; static_assert(ACT == 0 || ACT == 1, "EpiBf16: ACT is 0 (none) or 1 (gelu_pk)");
    bf16_t* O; int ldc; const float* bias; int split_cols; size_t split_stride; float scale0;
    __device__ __forceinline__ void operator()(const f32x4 (&acc)[2][2][4][2], const Unit& u, int wr, int wc, int fr, int fq) const {
        const int row0 = u.pm * BM + wr * 64 + fr; int colt = u.pn * BM; bf16_t* base = O;
        float sc = 1.f; if (split_cols) { const int t = colt / split_cols; base += (size_t)t * split_stride; colt -= t * split_cols; if (t == 0) sc = scale0; }
        const int col0 = colt + wc * 32 + 8 * fq, bcol0 = u.pn * BM + wc * 32 + 8 * fq;
        f32x4 bv[2][2];
#pragma unroll
        for (int bj = 0; bj < 2; ++bj)
#pragma unroll
            for (int n = 0; n < 2; ++n) bv[bj][n] = bias ? *(const f32x4*)(bias + bcol0 + bj * HALF + 4 * n) : (f32x4){0.f, 0.f, 0.f, 0.f};
#pragma unroll
        for (int ai = 0; ai < 2; ++ai)
#pragma unroll
            for (int m = 0; m < 4; ++m) { bf16_t* rowp = base + (size_t)(row0 + ai * HALF + m * 16) * ldc + col0;
#pragma unroll
                for (int bj = 0; bj < 2; ++bj) { f32x4 v0 = acc[ai][bj][m][0] + bv[bj][0], v1 = acc[ai][bj][m][1] + bv[bj][1];
                    if (ACT == 1) { f32x2 a = gelu_pk((f32x2){v0[0], v0[1]}), b = gelu_pk((f32x2){v0[2], v0[3]}), c = gelu_pk((f32x2){v1[0], v1[1]}), d = gelu_pk((f32x2){v1[2], v1[3]});
                        v0 = (f32x4){a.x, a.y, b.x, b.y}; v1 = (f32x4){c.x, c.y, d.x, d.y}; }
                    v0 = v0 * sc; v1 = v1 * sc; u32x4 w; w.x = cvt_pk_bf16(v0[0], v0[1]); w.y = cvt_pk_bf16(v0[2], v0[3]); w.z = cvt_pk_bf16(v1[0], v1[1]); w.w = cvt_pk_bf16(v1[2], v1[3]);
                    *(u32x4*)(rowp + bj * HALF) = w; } }
    }
};

struct PanelStats {
    unsigned* xbuf;
    unsigned* cnt;
    unsigned* tmo;
    int ntn; float eps;
    unsigned code;
    __device__ __forceinline__ bool run(const f32x4 (&v)[2][2][4][2], const Unit& u, int wr, int wc, int fr, int fq, PG8_LAS unsigned char* lds, int wid, int lane) const {
        typedef float f32x2v __attribute__((ext_vector_type(2)));
        PG8_LAS f32x2v* P = (PG8_LAS f32x2v*)lds;
        PG8_LAS f32x2v* S = (PG8_LAS f32x2v*)(lds + 8192);
        PG8_LAS unsigned* flag = (PG8_LAS unsigned*)(lds + 8192 + 2048);
#pragma unroll
        for (int ai = 0; ai < 2; ++ai)
#pragma unroll
            for (int m = 0; m < 4; ++m) {
                float s = 0.f;
#pragma unroll
                for (int bj = 0; bj < 2; ++bj)
#pragma unroll
                    for (int n = 0; n < 2; ++n) { const f32x4 x = v[ai][bj][m][n]; s += (x[0] + x[1]) + (x[2] + x[3]); }
                s += __shfl_xor(s, 16); s += __shfl_xor(s, 32);
                const float mw = s * (1.0f / 64.0f); float q = 0.f;
#pragma unroll
                for (int bj = 0; bj < 2; ++bj)
#pragma unroll
                    for (int n = 0; n < 2; ++n) { const f32x4 d = v[ai][bj][m][n] - mw; q += (d[0] * d[0] + d[1] * d[1]) + (d[2] * d[2] + d[3] * d[3]); }
                q += __shfl_xor(q, 16); q += __shfl_xor(q, 32);
                if (fq == 0) P[(ai * HALF + wr * 64 + m * 16 + fr) * 4 + wc] = (f32x2v){mw, q};
            }
        asm volatile("s_waitcnt lgkmcnt(0)" ::: "memory"); __builtin_amdgcn_s_barrier(); asm volatile("" ::: "memory");
#if defined(BROKEN_EXCHANGE_NO_WAIT)
#warning BROKEN CONTROL BUILD: the row-statistics exchange does not wait; results are wrong by design
        if (blockIdx.x >= 64) { const long long t0_ = clock64(); while (clock64() - t0_ < 60000) __builtin_amdgcn_s_sleep(8); }
#endif
        const int row = wid * 32 + (lane & 31);
        if (lane < 32) {
            const f32x2v a = P[row * 4 + 0], b = P[row * 4 + 1], c = P[row * 4 + 2], d = P[row * 4 + 3];
            const float mt = (a.x + b.x + c.x + d.x) * 0.25f;
            const float da = a.x - mt, db = b.x - mt, dc = c.x - mt, dd = d.x - mt;
            const float m2 = (a.y + b.y) + (c.y + d.y) + 64.0f * ((da * da + db * db) + (dc * dc + dd * dd));
            unsigned long long* slot = (unsigned long long*)xbuf + ((size_t)(u.pm * BM + row) * 4 + u.pn);
            __hip_atomic_store(slot, ((unsigned long long)__float_as_uint(m2) << 32) | __float_as_uint(mt), __ATOMIC_RELAXED, __HIP_MEMORY_SCOPE_AGENT);
        }
        asm volatile("s_waitcnt vmcnt(0)" ::: "memory");
        if (lane == 0) __hip_atomic_fetch_add(cnt + 64 * u.pm, 1u, __ATOMIC_RELAXED, __HIP_MEMORY_SCOPE_AGENT);
        if (wid == 0) {
            bool dead = false; const unsigned long long t0 = __builtin_amdgcn_s_memrealtime(); const unsigned want = 8u * (unsigned)ntn;
            for (;;) {
#if defined(BROKEN_EXCHANGE_NO_WAIT)
                break;
#endif
                if ((unsigned)__builtin_amdgcn_readfirstlane(__hip_atomic_load(cnt + 64 * u.pm, __ATOMIC_RELAXED, __HIP_MEMORY_SCOPE_AGENT)) >= want) break;
                if (__builtin_amdgcn_s_memrealtime() - t0 > 2000000ull) {
                    if (lane == 0) { unsigned expect = 0u; __hip_atomic_compare_exchange_strong(tmo + 1, &expect, code | (unsigned)(u.pm & 0xff), __ATOMIC_RELAXED, __ATOMIC_RELAXED, __HIP_MEMORY_SCOPE_AGENT);
                                     __hip_atomic_store(tmo, 1u, __ATOMIC_RELAXED, __HIP_MEMORY_SCOPE_AGENT); }
                    dead = true; break; }
                __builtin_amdgcn_s_sleep(2);
            }
            __builtin_amdgcn_fence(__ATOMIC_ACQUIRE, "agent");
            if (lane == 0) flag[0] = dead ? 1u : 0u;
        }
        asm volatile("s_waitcnt vmcnt(0) lgkmcnt(0)" ::: "memory"); __builtin_amdgcn_s_barrier(); asm volatile("" ::: "memory");
        const bool bad = flag[0] != 0u;
        if (lane < 32) {
            const unsigned long long* slot = (const unsigned long long*)xbuf + (size_t)(u.pm * BM + row) * 4; float mt[4], m2[4]; float ms = 0.f;
#pragma unroll
            for (int t = 0; t < 4; ++t) { if (t < ntn) { const unsigned long long w = __hip_atomic_load(slot + t, __ATOMIC_RELAXED, __HIP_MEMORY_SCOPE_AGENT); mt[t] = __uint_as_float((unsigned)w); m2[t] = __uint_as_float((unsigned)(w >> 32)); } else { mt[t] = 0.f; m2[t] = 0.f; } ms += mt[t]; }
            const float mean = ms / (float)ntn; float q = 0.f;
#pragma unroll
            for (int t = 0; t < 4; ++t) if (t < ntn) { const float dm = mt[t] - mean; q += m2[t] + 256.0f * dm * dm; }
            S[row] = (f32x2v){mean, 1.0f / sqrtf(q / (256.0f * (float)ntn) + eps)};
        }
        asm volatile("s_waitcnt lgkmcnt(0)" ::: "memory"); __builtin_amdgcn_s_barrier(); asm volatile("" ::: "memory");
        return bad;
    }
};
struct EpiLnRes {
    static constexpr bool PERM = false, AFTER_DRAIN = true;
    const float* base; float* out; int ldc; const float* bias; PanelStats st; unsigned poison;
    __device__ __forceinline__ void fused(f32x4 (&acc)[2][2][4][2], const Unit& u, int wr, int wc, int fr, int fq, PG8_LAS unsigned char* lds, int wid, int lane) const {
        typedef float f32x2v __attribute__((ext_vector_type(2)));
        const PG8_LAS f32x2v* S = (const PG8_LAS f32x2v*)(lds + 8192);
        const int col0 = u.pn * BM + wc * 32 + 4 * fq;
#pragma unroll
        for (int bj = 0; bj < 2; ++bj)
#pragma unroll
            for (int n = 0; n < 2; ++n) { const f32x4 bv = bias ? *(const f32x4*)(bias + col0 + bj * HALF + n * 16) : (f32x4){0.f, 0.f, 0.f, 0.f};
#pragma unroll
                for (int ai = 0; ai < 2; ++ai)
#pragma unroll
                    for (int m = 0; m < 4; ++m) acc[ai][bj][m][n] += bv; }
        f32x4 pre[4][2][2];
#pragma unroll
        for (int m = 0; m < 4; ++m) { const size_t off = (size_t)(u.pm * BM + wr * 64 + m * 16 + fr) * ldc + col0;
#pragma unroll
            for (int bj = 0; bj < 2; ++bj)
#pragma unroll
                for (int n = 0; n < 2; ++n) pre[m][bj][n] = *(const f32x4*)(base + off + bj * HALF + n * 16); }
        const bool bad = st.run(acc, u, wr, wc, fr, fq, lds, wid, lane) || poison != 0u;
        const float qnan = __builtin_nanf("");
#pragma unroll
        for (int ai = 0; ai < 2; ++ai)
#pragma unroll
            for (int m = 0; m < 4; ++m) { const int r = ai * HALF + wr * 64 + m * 16 + fr; const f32x2v sr = S[r]; const size_t off = (size_t)(u.pm * BM + r) * ldc + col0;
#pragma unroll
                for (int bj = 0; bj < 2; ++bj)
#pragma unroll
                    for (int n = 0; n < 2; ++n) { const f32x4 bs = ai == 0 ? pre[m][bj][n] : *(const f32x4*)(base + off + bj * HALF + n * 16); f32x4 o = bs + (acc[ai][bj][m][n] - sr.x) * sr.y;
                        if (bad) o = (f32x4){qnan, qnan, qnan, qnan}; *(f32x4*)(out + off + bj * HALF + n * 16) = o; }
                if (m & 1) asm volatile("" ::: "memory"); }
    }
};
struct EpiLnResLn {
    static constexpr bool PERM = false, AFTER_DRAIN = true;
    const float* base; float* out; bf16_t* xn; int ldc; const float* bias; PanelStats st1, st2; unsigned poison;
    __device__ __forceinline__ void fused(f32x4 (&acc)[2][2][4][2], const Unit& u, int wr, int wc, int fr, int fq, PG8_LAS unsigned char* lds, int wid, int lane) const {
        typedef float f32x2v __attribute__((ext_vector_type(2))); typedef unsigned u32x2v __attribute__((ext_vector_type(2)));
        const PG8_LAS f32x2v* S = (const PG8_LAS f32x2v*)(lds + 8192);
        const int col0 = u.pn * BM + wc * 32 + 4 * fq;
#pragma unroll
        for (int bj = 0; bj < 2; ++bj)
#pragma unroll
            for (int n = 0; n < 2; ++n) { const f32x4 bv = bias ? *(const f32x4*)(bias + col0 + bj * HALF + n * 16) : (f32x4){0.f, 0.f, 0.f, 0.f};
#pragma unroll
                for (int ai = 0; ai < 2; ++ai)
#pragma unroll
                    for (int m = 0; m < 4; ++m) acc[ai][bj][m][n] += bv; }
        bool bad = st1.run(acc, u, wr, wc, fr, fq, lds, wid, lane) || poison != 0u;
        const float qnan = __builtin_nanf("");
#pragma unroll
        for (int ai = 0; ai < 2; ++ai)
#pragma unroll
            for (int m = 0; m < 4; ++m) { const int r = ai * HALF + wr * 64 + m * 16 + fr; const f32x2v sr = S[r]; const size_t off = (size_t)(u.pm * BM + r) * ldc + col0;
#pragma unroll
                for (int bj = 0; bj < 2; ++bj)
#pragma unroll
                    for (int n = 0; n < 2; ++n) { const f32x4 bs = *(const f32x4*)(base + off + bj * HALF + n * 16); acc[ai][bj][m][n] = bs + (acc[ai][bj][m][n] - sr.x) * sr.y; }
                asm volatile("" : "+v"(acc[ai][0][m][0]), "+v"(acc[ai][0][m][1]), "+v"(acc[ai][1][m][0]), "+v"(acc[ai][1][m][1]));
                if (m & 1) asm volatile("" ::: "memory"); }
        const bool bad1 = bad;
        bad = st2.run(acc, u, wr, wc, fr, fq, lds, wid, lane) || bad;
#pragma unroll
        for (int ai = 0; ai < 2; ++ai)
#pragma unroll
            for (int m = 0; m < 4; ++m) { const int r = ai * HALF + wr * 64 + m * 16 + fr; const f32x2v sr = S[r]; const size_t off = (size_t)(u.pm * BM + r) * ldc + col0;
#pragma unroll
                for (int bj = 0; bj < 2; ++bj)
#pragma unroll
                    for (int n = 0; n < 2; ++n) { const f32x4 x1 = acc[ai][bj][m][n]; *(f32x4*)(out + off + bj * HALF + n * 16) = bad1 ? (f32x4){qnan, qnan, qnan, qnan} : x1;
                        const f32x4 o = (x1 - sr.x) * sr.y; u32x2v w; w.x = cvt_pk_bf16(o[0], o[1]); w.y = cvt_pk_bf16(o[2], o[3]);
                        if (bad) { w.x = 0x7fc07fc0u; w.y = 0x7fc07fc0u; } *(u32x2v*)(xn + off + bj * HALF + n * 16) = w; }
                asm volatile("" ::: "memory"); }
    }
};

template <class Epi, class Sched, bool ALIGN_EPI = false, bool SP2 = false>
__device__ __forceinline__ void gemm_phase(PG8_LAS unsigned char* lds, const Gemm g, const Sched& S, const Epi& E) {
    const int tid = threadIdx.x, wid = __builtin_amdgcn_readfirstlane(tid >> 6), lane = tid & 63, wr = wid >> 2, wc = wid & 3, fr = lane & 15, fq = lane >> 4;
    const int K = g.K, nt = K / BK;
    unsigned voffA[2], voffB[2];
#pragma unroll
    for (int i = 0; i < 2; ++i) { int R, C; stage_rc(tid * 16 + i * 8192, R, C); const int Rb = Epi::PERM ? ((R & ~31) + perm32(R & 31)) : R;
        voffA[i] = (unsigned)(R * K + C) * 2u; voffB[i] = (unsigned)(Rb * K + C) * 2u; }
    const size_t kstep = (size_t)(BK * 2);
    const size_t hstep = (size_t)HALF * K * 2;
    const size_t tstep = 2 * hstep;
    const unsigned ldsw = (unsigned)wid * 1024u;
    const int aoff = lds_byte(wr * 64 + fr, fq * 8), boff = lds_byte(wc * 32 + fr, fq * 8);
#define PG8_SA(b, h) (((b) * 2 + (h)) * HTB)
#define PG8_SB(b, h) ((4 + (b) * 2 + (h)) * HTB)
#define PG8_STAGE(bufoff, gbase, voff) do { _Pragma("unroll") for (int _i = 0; _i < 2; ++_i) \
        __builtin_amdgcn_global_load_lds((const unsigned*)((const char*)(gbase) + (voff)[_i]), (PG8_LAS unsigned*)(lds + (bufoff) + ldsw + _i * 8192), 16, 0, 0); } while (0)
#define PG8_LDA(dst, b, h) do { _Pragma("unroll") for (int m = 0; m < 4; ++m) _Pragma("unroll") for (int k = 0; k < 2; ++k) dst[m][k] = *(const PG8_LAS bf16x8*)(lds + PG8_SA(b, h) + aoff + m * 2048 + k * 1024); } while (0)
#define PG8_LDB(dst, b, h) do { _Pragma("unroll") for (int n = 0; n < 2; ++n) _Pragma("unroll") for (int k = 0; k < 2; ++k) dst[n][k] = *(const PG8_LAS bf16x8*)(lds + PG8_SB(b, h) + boff + n * 2048 + k * 1024); } while (0)
#define PG8_MMA(ai, bj, At, Bt) do { __builtin_amdgcn_s_setprio(1); _Pragma("unroll") for (int m = 0; m < 4; ++m) _Pragma("unroll") for (int n = 0; n < 2; ++n) _Pragma("unroll") for (int k = 0; k < 2; ++k) \
        acc[ai][bj][m][n] = __builtin_amdgcn_mfma_f32_16x16x32_bf16(Bt[n][k], At[m][k], acc[ai][bj][m][n], 0, 0, 0); __builtin_amdgcn_s_setprio(0); } while (0)
#define PG8_WAIT_V(n) asm volatile("s_waitcnt vmcnt(" #n ")" ::: "memory")
#define PG8_WAIT_L(n) asm volatile("s_waitcnt lgkmcnt(" #n ")" ::: "memory")
#define PG8_BAR __builtin_amdgcn_s_barrier()
#define PG8_SCHED __builtin_amdgcn_sched_barrier(0)
    Unit cur, nxt; int ui = 0;
    if (!S.next(0, cur)) return;
    f32x4 acc[2][2][4][2];
#pragma unroll
    for (int a = 0; a < 2; ++a)
#pragma unroll
        for (int b = 0; b < 2; ++b)
#pragma unroll
            for (int m = 0; m < 4; ++m)
#pragma unroll
                for (int n = 0; n < 2; ++n) acc[a][b][m][n] = (f32x4){0.f, 0.f, 0.f, 0.f};
    bf16x8 At[4][2], B0[2][2], B1[2][2];
    const char* cA = (const char*)g.A + (size_t)cur.pm * tstep; const char* cB = (const char*)g.Bt + (size_t)cur.pn * tstep;
    S.a_ready(cur);
    if constexpr (SP2) {
        PG8_STAGE(PG8_SB(0, 0), cB, voffB); PG8_STAGE(PG8_SB(0, 1), cB + hstep, voffB); PG8_STAGE(PG8_SA(0, 0), cA, voffA); PG8_STAGE(PG8_SA(0, 1), cA + hstep, voffA);
        if (wr == 1) PG8_BAR;
        PG8_WAIT_V(2); PG8_BAR;
        PG8_STAGE(PG8_SB(1, 0), cB + kstep, voffB); PG8_STAGE(PG8_SA(1, 0), cA + kstep, voffA); PG8_STAGE(PG8_SB(1, 1), cB + hstep + kstep, voffB);
        PG8_WAIT_V(6); PG8_BAR;
    } else {
        PG8_STAGE(PG8_SB(0, 0), cB, voffB); PG8_STAGE(PG8_SA(0, 0), cA, voffA); PG8_STAGE(PG8_SB(0, 1), cB + hstep, voffB); PG8_STAGE(PG8_SA(0, 1), cA + hstep, voffA);
        if (wr == 1) PG8_BAR;
        PG8_WAIT_V(4); PG8_BAR;
        PG8_STAGE(PG8_SB(1, 0), cB + kstep, voffB); PG8_STAGE(PG8_SA(1, 0), cA + kstep, voffA); PG8_STAGE(PG8_SB(1, 1), cB + hstep + kstep, voffB);
        PG8_WAIT_V(6); PG8_BAR;
    }
    for (;;) {
        const bool has_next = S.next(ui + 1, nxt);
        const char* nA = has_next ? (const char*)g.A + (size_t)nxt.pm * tstep : cA; const char* nB = has_next ? (const char*)g.Bt + (size_t)nxt.pn * tstep : cB;
        for (int t = 0; t < nt; t += 2) {
            const bool last = (t == nt - 2);
            const char* a1 = cA + (size_t)(t + 1) * kstep;
            const char* a2 = last ? nA : cA + (size_t)(t + 2) * kstep; const char* b2 = last ? nB : cB + (size_t)(t + 2) * kstep;
            const char* a3 = a2 + kstep; const char* b3 = b2 + kstep;
            if (last && has_next) S.a_ready(nxt);
            if constexpr (SP2) {
            PG8_LDB(B0, 0, 0); PG8_LDB(B1, 0, 1); PG8_SCHED; PG8_LDA(At, 0, 0); PG8_STAGE(PG8_SA(1, 1), a1 + hstep, voffA);
            PG8_WAIT_V(8); PG8_WAIT_L(0); PG8_BAR; PG8_MMA(0, 0, At, B0); PG8_MMA(0, 1, At, B1); PG8_BAR; PG8_SCHED;
            PG8_LDA(At, 0, 1); PG8_STAGE(PG8_SB(0, 0), b2, voffB); PG8_STAGE(PG8_SB(0, 1), b2 + hstep, voffB); PG8_STAGE(PG8_SA(0, 0), a2, voffA);
            PG8_WAIT_V(8); PG8_WAIT_L(0); PG8_BAR; PG8_MMA(1, 0, At, B0); PG8_MMA(1, 1, At, B1); PG8_BAR; PG8_SCHED;
            PG8_LDB(B0, 1, 0); PG8_LDB(B1, 1, 1); PG8_SCHED; PG8_LDA(At, 1, 0); PG8_STAGE(PG8_SA(0, 1), a2 + hstep, voffA);
            PG8_WAIT_V(8); PG8_WAIT_L(0); PG8_BAR; PG8_MMA(0, 0, At, B0); PG8_MMA(0, 1, At, B1); PG8_BAR; PG8_SCHED;
            PG8_LDA(At, 1, 1); PG8_STAGE(PG8_SB(1, 0), b3, voffB); PG8_STAGE(PG8_SB(1, 1), b3 + hstep, voffB); PG8_STAGE(PG8_SA(1, 0), a3, voffA);
            PG8_WAIT_V(8); PG8_WAIT_L(0); PG8_BAR; PG8_MMA(1, 0, At, B0); PG8_MMA(1, 1, At, B1); PG8_BAR; PG8_SCHED;
            } else {
            PG8_LDB(B0, 0, 0); PG8_SCHED; PG8_LDA(At, 0, 0); PG8_STAGE(PG8_SA(1, 1), a1 + hstep, voffA);
            PG8_WAIT_L(8); PG8_BAR; PG8_WAIT_L(0); PG8_MMA(0, 0, At, B0); PG8_BAR; PG8_SCHED;
            PG8_LDB(B1, 0, 1); PG8_STAGE(PG8_SB(0, 0), b2, voffB);
            PG8_BAR; PG8_WAIT_L(0); PG8_MMA(0, 1, At, B1); PG8_BAR;
            PG8_LDA(At, 0, 1); PG8_STAGE(PG8_SA(0, 0), a2, voffA);
            PG8_BAR; PG8_WAIT_L(0); PG8_MMA(1, 0, At, B0); PG8_BAR; PG8_SCHED;
            PG8_STAGE(PG8_SB(0, 1), b2 + hstep, voffB);
            PG8_WAIT_V(6); PG8_BAR; PG8_MMA(1, 1, At, B1); PG8_BAR;
            PG8_LDB(B0, 1, 0); PG8_SCHED; PG8_LDA(At, 1, 0); PG8_STAGE(PG8_SA(0, 1), a2 + hstep, voffA);
            PG8_WAIT_L(8); PG8_BAR; PG8_WAIT_L(0); PG8_MMA(0, 0, At, B0); PG8_BAR; PG8_SCHED;
            PG8_LDB(B1, 1, 1); PG8_STAGE(PG8_SB(1, 0), b3, voffB);
            PG8_BAR; PG8_WAIT_L(0); PG8_MMA(0, 1, At, B1); PG8_BAR;
            PG8_LDA(At, 1, 1); PG8_STAGE(PG8_SA(1, 0), a3, voffA);
            PG8_BAR; PG8_WAIT_L(0); PG8_MMA(1, 0, At, B0); PG8_BAR; PG8_SCHED;
            PG8_STAGE(PG8_SB(1, 1), b3 + hstep, voffB);
            PG8_WAIT_V(6); PG8_BAR; PG8_MMA(1, 1, At, B1); PG8_BAR;
            }
        }
        if constexpr (ALIGN_EPI) { if (wr == 0) PG8_BAR; }
        if constexpr (!Epi::AFTER_DRAIN) { E(acc, cur, wr, wc, fr, fq); S.done(cur); }
        if (!has_next) break;
#pragma unroll
        for (int a = 0; a < 2; ++a)
#pragma unroll
            for (int b = 0; b < 2; ++b)
#pragma unroll
                for (int m = 0; m < 4; ++m)
#pragma unroll
                    for (int n = 0; n < 2; ++n) acc[a][b][m][n] = (f32x4){0.f, 0.f, 0.f, 0.f};
        cur = nxt; cA = nA; cB = nB; ++ui;
        if constexpr (ALIGN_EPI) { if (wr == 1) PG8_BAR; }
    }
    PG8_WAIT_V(0);
    if constexpr (!ALIGN_EPI) { if (wr == 0) PG8_BAR; }
    PG8_BAR;
    if constexpr (Epi::AFTER_DRAIN) { E.fused(acc, cur, wr, wc, fr, fq, lds, wid, lane); S.done(cur); }
#undef PG8_SA
#undef PG8_SB
#undef PG8_STAGE
#undef PG8_LDA
#undef PG8_LDB
#undef PG8_MMA
#undef PG8_WAIT_V
#undef PG8_WAIT_L
#undef PG8_BAR
#undef PG8_SCHED
}
}
namespace pg8 {
__device__ __forceinline__ float silu_mul(float g, float u) { return g * __builtin_amdgcn_rcpf(1.f + __builtin_amdgcn_exp2f(-1.4426950408889634f * g)) * u; }
struct EpiSwiGLU {
    static constexpr bool PERM = true, AFTER_DRAIN = false;
    bf16_t* O; int ldc;
    __device__ __forceinline__ void operator()(const f32x4 (&acc)[2][2][4][2], const Unit& u, int wr, int wc, int fr, int fq) const {
        const int row0 = u.pm * BM + wr * 64 + fr, col0 = u.pn * HALF + wc * 32 + 8 * fq;
#pragma unroll
        for (int ai = 0; ai < 2; ++ai)
#pragma unroll
            for (int m = 0; m < 4; ++m) { bf16_t* rowp = O + (size_t)(row0 + ai * HALF + m * 16) * ldc + col0;
                const f32x4 g0 = acc[ai][0][m][0], g1 = acc[ai][0][m][1], u0 = acc[ai][1][m][0], u1 = acc[ai][1][m][1];
                u32x4 w; w.x = cvt_pk_bf16(silu_mul(g0[0], u0[0]), silu_mul(g0[1], u0[1])); w.y = cvt_pk_bf16(silu_mul(g0[2], u0[2]), silu_mul(g0[3], u0[3]));
                w.z = cvt_pk_bf16(silu_mul(g1[0], u1[0]), silu_mul(g1[1], u1[1])); w.w = cvt_pk_bf16(silu_mul(g1[2], u1[2]), silu_mul(g1[3], u1[3]));
                *(u32x4*)rowp = w; }
    }
};
struct EpiF32 {
    static constexpr bool PERM = false, AFTER_DRAIN = false;
    float* O; int ldc;
    __device__ __forceinline__ void operator()(const f32x4 (&acc)[2][2][4][2], const Unit& u, int wr, int wc, int fr, int fq) const {
        const int row0 = u.pm * BM + wr * 64 + fr, col0 = u.pn * BM + wc * 32 + 4 * fq;
#pragma unroll
        for (int ai = 0; ai < 2; ++ai)
#pragma unroll
            for (int m = 0; m < 4; ++m) { float* rowp = O + (size_t)(row0 + ai * HALF + m * 16) * ldc + col0;
#pragma unroll
                for (int bj = 0; bj < 2; ++bj)
#pragma unroll
                    for (int n = 0; n < 2; ++n) *(f32x4*)(rowp + bj * HALF + n * 16) = acc[ai][bj][m][n]; }
    }
};
struct EpiWin {
    static constexpr bool PERM = false, AFTER_DRAIN = false;
    bf16_t* QKV; float* PR; float* kout; float* vout; float* kout_s; float* vout_s; float* shift_p; float* shift_s; float qscale; int MPr, SEQr;
    __device__ __forceinline__ void operator()(const f32x4 (&acc)[2][2][4][2], const Unit& u, int wr, int wc, int fr, int fq) const {
        typedef unsigned u32x2v __attribute__((ext_vector_type(2)));
        const int ct = u.pn, row0 = u.pm * BM + wr * 64 + fr, colt = wc * 32 + 4 * fq;
        const bool samp = (u.pm * BM) >= MPr;
#pragma unroll
        for (int ai = 0; ai < 2; ++ai)
#pragma unroll
            for (int m = 0; m < 4; ++m) { const int row = row0 + ai * HALF + m * 16;
#pragma unroll
                for (int bj = 0; bj < 2; ++bj)
#pragma unroll
                    for (int n = 0; n < 2; ++n) { const int c = ct * BM + colt + bj * HALF + n * 16; const f32x4 v = acc[ai][bj][m][n];
                        if (ct < 6) { const float sc = ct < 2 ? qscale : 1.f; u32x2v w; w.x = cvt_pk_bf16(v[0] * sc, v[1] * sc); w.y = cvt_pk_bf16(v[2] * sc, v[3] * sc);
                            *(u32x2v*)(QKV + (size_t)row * 1536 + c) = w;
                            if (ct >= 2) { float* ob = (ct < 4) ? (samp ? kout_s + (size_t)(row - MPr) * 512 : kout + (size_t)row * 512) + (c - 512)
                                                                  : (samp ? vout_s + (size_t)(row - MPr) * 512 : vout + (size_t)row * 512) + (c - 1024);
                                *(f32x4*)ob = v; } }
                        else { const int pc = c - 1536; *(f32x4*)(PR + (size_t)row * 1792 + pc) = v;
                            if (!samp) { if ((row & (SEQr - 1)) == SEQr - 1) *(f32x4*)(shift_p + (size_t)(row / SEQr) * 1792 + pc) = v; }
                            else { const int rs = row - MPr; if ((rs & 3) == 3) *(f32x4*)(shift_s + (size_t)(rs >> 2) * 1792 + pc) = v; } } } }
    }
};
}
#include <hip/hip_bf16.h>
#include <cmath>
namespace attn_body {
using bf16=__hip_bfloat16;
using bf16x8=__attribute__((ext_vector_type(8)))short;
using s16x4=__attribute__((ext_vector_type(4)))short;
using f32x16=__attribute__((ext_vector_type(16)))float;
using u32x4=__attribute__((ext_vector_type(4)))unsigned;
constexpr int SEQ=2048,D=64,PQ=1536,PO=1024;
constexpr int NW=8,QBLK=32,QB=QBLK*NW,KVBLK=64,NQB=SEQ/QB;
constexpr int ATTN_UNIT_ROWS=QB;
__device__ __forceinline__ int crow(int r,int hi){return (r&3)+8*(r>>2)+4*hi;}
#define SBAR() __builtin_amdgcn_sched_barrier(0)
typedef __attribute__((address_space(3))) const float* lds_cfptr;
__device__ __forceinline__ void cbias(f32x16&p0,f32x16&p1,int jb,int qrel,int hi,lds_cfptr R){
  const int nb=qrel-64*(jb-2)-4*hi; lds_cfptr rp=R+(383-nb);
  #pragma unroll
  for(int r=0;r<16;++r){const int off=(r&3)+8*(r>>2); p0[r]+=rp[off]; p1[r]+=rp[off+32];}
}

constexpr int NSLOT=3, SLOTB=8192;
constexpr int LDS_K=0, LDS_V=NSLOT*SLOTB, LDS_WS=2*NSLOT*SLOTB, LDS_OST=LDS_WS+NW*64*4, LDS_BYTES=LDS_OST+NW*4096;
constexpr float C2=0.125f*1.4426950408889634f;
__device__ __forceinline__ void glds16(const void*gsrc,unsigned lds_dst){unsigned keep;
  asm volatile("s_mov_b32 %0, m0\n\ts_mov_b32 m0, %2\n\ts_nop 0\n\tglobal_load_lds_dwordx4 %1, off\n\ts_mov_b32 m0, %0":"=&s"(keep):"v"(gsrc),"s"(lds_dst):"memory");}
__device__ __forceinline__ float max3f(float a,float b,float c){float r;asm("v_max3_f32 %0, %1, %2, %3":"=v"(r):"v"(a),"v"(b),"v"(c));return r;}
__device__ __forceinline__ float max2f(float a,float b){float r;asm("v_max_f32_e32 %0, %1, %2":"=v"(r):"v"(a),"v"(b));return r;}
__device__ __forceinline__ float fadd_s(float a,float b){float r;asm("v_add_f32_e32 %0, %1, %2":"=v"(r):"v"(a),"v"(b));return r;}
__device__ __forceinline__ float fsub_s(float a,float b){float r;asm("v_sub_f32_e32 %0, %1, %2":"=v"(r):"v"(a),"v"(b));return r;}
typedef float f32x2_t __attribute__((ext_vector_type(2))); typedef __bf16 bf16x2_t __attribute__((ext_vector_type(2)));
__device__ __forceinline__ unsigned cvtpk_s(float lo,float hi){f32x2_t v={lo,hi};bf16x2_t b=__builtin_convertvector(v,bf16x2_t);return __builtin_bit_cast(unsigned,b);}
#define WAIT_BAR(N) asm volatile("s_waitcnt vmcnt(" #N ") lgkmcnt(0)\n\ts_barrier":::"memory")

__device__ __forceinline__ void qkt(f32x16&p0,f32x16&p1,const char*Kslot,const bf16x8*qr,const f32x16&negm,int r32,int hi){
  const char*kb=Kslot+hi*1024+r32*16;
  #pragma unroll
  for(int d0=0;d0<4;++d0){
    const bf16x8 b0=*reinterpret_cast<const bf16x8*>(kb+d0*2048);
    const bf16x8 b1=*reinterpret_cast<const bf16x8*>(kb+d0*2048+512);
    if(d0==0){p0=__builtin_amdgcn_mfma_f32_32x32x16_bf16(b0,qr[0],negm,0,0,0);p1=__builtin_amdgcn_mfma_f32_32x32x16_bf16(b1,qr[0],negm,0,0,0);}
    else{p0=__builtin_amdgcn_mfma_f32_32x32x16_bf16(b0,qr[d0],p0,0,0,0);p1=__builtin_amdgcn_mfma_f32_32x32x16_bf16(b1,qr[d0],p1,0,0,0);}}
}
typedef __attribute__((address_space(3))) const char* lds_cptr;
typedef short v4i16_t __attribute__((ext_vector_type(4)));
__device__ __forceinline__ void kload8(bf16x8*kf,lds_cptr kp){
  kf[0]=*(const __attribute__((address_space(3))) bf16x8*)(kp);      kf[1]=*(const __attribute__((address_space(3))) bf16x8*)(kp+512);
  kf[2]=*(const __attribute__((address_space(3))) bf16x8*)(kp+2048); kf[3]=*(const __attribute__((address_space(3))) bf16x8*)(kp+2560);
  kf[4]=*(const __attribute__((address_space(3))) bf16x8*)(kp+4096); kf[5]=*(const __attribute__((address_space(3))) bf16x8*)(kp+4608);
  kf[6]=*(const __attribute__((address_space(3))) bf16x8*)(kp+6144); kf[7]=*(const __attribute__((address_space(3))) bf16x8*)(kp+6656);
}
__device__ __forceinline__ void kload2(bf16x8*kf,lds_cptr kp,int j){ kf[2*j]=*(const __attribute__((address_space(3))) bf16x8*)(kp+j*2048); kf[2*j+1]=*(const __attribute__((address_space(3))) bf16x8*)(kp+j*2048+512); }
__device__ __forceinline__ s16x4 vtr(lds_cptr p){ return __builtin_bit_cast(s16x4,__builtin_amdgcn_ds_read_tr16_b64_v4i16((__attribute__((address_space(3))) v4i16_t*)p)); }
__device__ __forceinline__ float rowmax(const f32x16&p0,const f32x16&p1){
  float a=max3f(p0[0],p0[1],p1[0]),b=max3f(p0[2],p0[3],p1[1]);a=max3f(a,p1[2],p1[3]);
  #pragma unroll
  for(int r=4;r<16;r+=4){a=max3f(a,p0[r],p0[r+1]);b=max3f(b,p0[r+2],p0[r+3]);a=max3f(a,p1[r],p1[r+1]);b=max3f(b,p1[r+2],p1[r+3]);}
  const float m=max2f(a,b);
  auto rr=__builtin_amdgcn_permlane32_swap(__float_as_uint(m),__float_as_uint(m),false,false);
  return max2f(__uint_as_float(rr[0]),__uint_as_float(rr[1]));
}
__device__ __forceinline__ void pv(f32x16*o,int vb,bf16x8 pa0,bf16x8 pa1,bf16x8 pa2,bf16x8 pa3){
  #pragma unroll
  for(int d0=0;d0<2;++d0){s16x4 lo[4],hi[4];
    #pragma unroll
    for(int ks=0;ks<4;++ks){
      asm volatile("ds_read_b64_tr_b16 %0,%1 offset:%c2":"=&v"(lo[ks]):"v"(vb),"i"(d0*4096+ks*1024):"memory");
      asm volatile("ds_read_b64_tr_b16 %0,%1 offset:%c2":"=&v"(hi[ks]):"v"(vb),"i"(d0*4096+ks*1024+512):"memory");}
    asm volatile("s_waitcnt lgkmcnt(0)":::"memory");SBAR();
    #define PK(k) (bf16x8){lo[k][0],lo[k][1],lo[k][2],lo[k][3],hi[k][0],hi[k][1],hi[k][2],hi[k][3]}
    o[d0]=__builtin_amdgcn_mfma_f32_32x32x16_bf16(pa0,PK(0),o[d0],0,0,0);
    o[d0]=__builtin_amdgcn_mfma_f32_32x32x16_bf16(pa1,PK(1),o[d0],0,0,0);
    o[d0]=__builtin_amdgcn_mfma_f32_32x32x16_bf16(pa2,PK(2),o[d0],0,0,0);
    o[d0]=__builtin_amdgcn_mfma_f32_32x32x16_bf16(pa3,PK(3),o[d0],0,0,0);
    #undef PK
  }
}

#ifndef ATTN_STORE16
#define ATTN_STORE16(p,v) (*(u32x4*)(p)=(v))
#endif
template<int THRL> __device__ __forceinline__ void attn_unit(int b,int qb,const bf16*Qc,const bf16*__restrict__ Kc,const bf16*__restrict__ Vc,bf16*Oc,lds_cfptr lutR,char*shm){
  const int tid=threadIdx.x,lane=tid&63,r32=lane&31,hi=lane>>5; const int wid=__builtin_amdgcn_readfirstlane(tid>>6);
  const long rowbase=(long)b*SEQ; const int q0=qb*QB;
  const bf16*Qw=Qc+(rowbase+q0+wid*QBLK)*PQ;
  const bf16*Kh=Kc+rowbase*PQ,*Vh=Vc+rowbase*PQ;
  const unsigned lds0=(unsigned)(uintptr_t)shm;
  float*wsf=(float*)(shm+LDS_WS)+wid*64;
  const bf16*ksrc=Kh+(long)lane*PQ+wid*8;
  const bf16*vsrc=Vh+(long)(16*(wid&3)+(lane>>2))*PQ+(wid>>2)*32+(lane&3)*8;
  const unsigned kdst=lds0+LDS_K+wid*1024, vdst=lds0+LDS_V+wid*1024;
  #define DMA_K(t,slot) glds16(ksrc+(long)(t)*KVBLK*PQ,(unsigned)__builtin_amdgcn_readfirstlane(kdst+(slot)))
  #define DMA_V(t,slot) glds16(vsrc+(long)(t)*KVBLK*PQ,(unsigned)__builtin_amdgcn_readfirstlane(vdst+(slot)))
  const int vb0=(int)(lds0+LDS_V)+((lane>>4)&1)*32+(lane&3)*8+(4*hi+((lane&15)>>2))*64;
  const char*Kbase=shm+LDS_K; bf16x8 kf[8];
  const lds_cptr shm3=(lds_cptr)shm; const lds_cptr kp0=shm3+LDS_K+hi*1024+r32*16; const lds_cptr vp0=shm3+LDS_V+((lane>>4)&1)*32+(lane&3)*8+(4*hi+((lane&15)>>2))*64;
  const int NT=(q0+QB)/KVBLK;
  DMA_K(0,0);DMA_V(0,0);DMA_K(1,SLOTB);
  bf16x8 qr[4];
  #pragma unroll
  for(int d0=0;d0<4;++d0)qr[d0]=*reinterpret_cast<const bf16x8*>(&Qw[(long)r32*PQ+d0*16+hi*8]);
  float mhat=0.f,l_reg=0.f;f32x16 o[2];o[0]=f32x16{};o[1]=f32x16{};f32x16 negm=f32x16{};asm volatile("":"+v"(negm));
  const int qrel=wid*QBLK+r32;
  #define CMASK(P0,P1,t) do{int jb_=(t)-(NT-6); if(jb_>=0)cbias(P0,P1,jb_,qrel,hi,lutR);}while(0)
  bool resc=false;
  #define START(P0,P1) do{ const float rm=rowmax(P0,P1); resc=false; \
    { const float dl=rm; mhat=fadd_s(mhat,dl); \
      _Pragma("unroll") for(int r=0;r<16;++r){P0[r]=fsub_s(P0[r],dl);P1[r]=fsub_s(P1[r],dl);} \
      _Pragma("unroll") for(int r=0;r<16;++r)negm[r]=-mhat; asm volatile("":"+v"(negm)); } \
    _Pragma("unroll") for(int r=0;r<16;++r)P0[r]=__builtin_amdgcn_exp2f(P0[r]); }while(0)
  #define RESC() do{ if(resc){ asm volatile("s_waitcnt lgkmcnt(0)":::"memory"); \
      _Pragma("unroll") for(int d_=0;d_<2;++d_) _Pragma("unroll") for(int r=0;r<16;++r)o[d_][r]*=wsf[crow(r,hi)]; } }while(0)
  f32x16 pA0,pA1,pB0,pB1;
  int sl_prev=0,sl_cur=0,sl_next=SLOTB;
  #define ROT() do{sl_prev=sl_cur;sl_cur=sl_next;sl_next=(sl_next==(NSLOT-1)*SLOTB)?0:sl_next+SLOTB;}while(0)
  DMA_K(2,2*SLOTB);
  WAIT_BAR(3);
  qkt(pA0,pA1,Kbase,qr,negm,r32,hi);asm volatile("s_nop 15\n\ts_nop 7":"+v"(pA0),"+v"(pA1));CMASK(pA0,pA1,0);
  START(pA0,pA1);
  _Pragma("unroll") for(int r=0;r<16;++r)pA1[r]=__builtin_amdgcn_exp2f(pA1[r]);
  WAIT_BAR(0);
  DMA_K(3,0);DMA_V(1,SLOTB);
  ROT();
  kload8(kf,kp0+sl_cur);
  WAIT_BAR(2);
  s16x4 vlo[8],vhi[8]; u32x4 pw0,pw1,pw2,pw3;
  #define PKW(P,B) cvtpk_s(P[B],P[B+1])
  #define PAF(k) __builtin_bit_cast(bf16x8,pw##k)
  #define VFR(i) (bf16x8){vlo[i][0],vlo[i][1],vlo[i][2],vlo[i][3],vhi[i][0],vhi[i][1],vhi[i][2],vhi[i][3]}
  #define PIN(x) asm volatile("":"+v"(x))
  #define MX3(a,b,c) __builtin_fmaxf(__builtin_fmaxf((a),(b)),(c))
  #define GAPA(MF,A0,A1,A2,A3,W0,W1,PW) do{ MF; sacc+=A0; sacc+=A1; sacc+=A2; sacc+=A3; PIN(sacc); W0; W1; PIN(PW); SBAR(); }while(0)
  #define EX(v) __builtin_amdgcn_exp2f(v)
  #define GAPB(MF,X,B) do{ MF; X[B]=EX(X[B]); X[B+1]=EX(X[B+1]); X[B+2]=EX(X[B+2]); X[B+3]=EX(X[B+3]); PIN(X); SBAR(); }while(0)
  #define VRD(i) do{ vlo[i]=vtr(vp_+(((i)>>2)*4096+((i)&3)*1024)); vhi[i]=vtr(vp_+(((i)>>2)*4096+((i)&3)*1024+512)); }while(0)
  #define KRD(G,j) do{ if(G){ kload2(kf,kp0+sl_next,j); SBAR(); } }while(0)
  #define STEP(C0,C1,P0,P1,t,GK,GV,GL) do{ SBAR(); \
    const lds_cptr vp_=vp0+sl_prev; \
    VRD(0); SBAR(); float sacc=(P0[0]+P0[1]); \
    GAPA(C0=__builtin_amdgcn_mfma_f32_32x32x16_bf16(kf[0],qr[0],negm,0,0,0), P0[2],P0[3],P0[4],P0[5],     pw0[0]=PKW(P0,0), pw0[1]=PKW(P0,2), pw0); \
    VRD(4); SBAR(); GAPA(C1=__builtin_amdgcn_mfma_f32_32x32x16_bf16(kf[1],qr[0],negm,0,0,0), P0[6],P0[7],P0[8],P0[9],     pw0[2]=PKW(P0,4), pw0[3]=PKW(P0,6), pw0); \
    VRD(1); SBAR(); GAPA(C0=__builtin_amdgcn_mfma_f32_32x32x16_bf16(kf[2],qr[1],C0,0,0,0),   P0[10],P0[11],P0[12],P0[13], pw1[0]=PKW(P0,8), pw1[1]=PKW(P0,10), pw1); \
    VRD(5); SBAR(); GAPA(C1=__builtin_amdgcn_mfma_f32_32x32x16_bf16(kf[3],qr[1],C1,0,0,0),   P0[14],P0[15],P1[0],P1[1],   pw1[2]=PKW(P0,12),pw1[3]=PKW(P0,14), pw1); \
    VRD(2); SBAR(); GAPA(C0=__builtin_amdgcn_mfma_f32_32x32x16_bf16(kf[4],qr[2],C0,0,0,0),   P1[2],P1[3],P1[4],P1[5],     pw2[0]=PKW(P1,0), pw2[1]=PKW(P1,2), pw2); \
    VRD(6); SBAR(); GAPA(C1=__builtin_amdgcn_mfma_f32_32x32x16_bf16(kf[5],qr[2],C1,0,0,0),   P1[6],P1[7],P1[8],P1[9],     pw2[2]=PKW(P1,4), pw2[3]=PKW(P1,6), pw2); \
    VRD(3); SBAR(); GAPA(C0=__builtin_amdgcn_mfma_f32_32x32x16_bf16(kf[6],qr[3],C0,0,0,0),   P1[10],P1[11],P1[12],P1[13], pw3[0]=PKW(P1,8), pw3[1]=PKW(P1,10), pw3); \
    VRD(7); SBAR(); GAPA(C1=__builtin_amdgcn_mfma_f32_32x32x16_bf16(kf[7],qr[3],C1,0,0,0),   P1[14],P1[15],0.f,0.f,       pw3[2]=PKW(P1,12),pw3[3]=PKW(P1,14), pw3); \
    l_reg+=sacc; \
    if(GK){DMA_K((t)+3,sl_cur);} if(GV){DMA_V((t)+1,sl_next);} \
    CMASK(C0,C1,t); \
    { float a=MX3(C0[0],C0[1],C1[0]),b=MX3(C0[2],C0[3],C1[1]); a=MX3(a,C1[2],C1[3]); \
      _Pragma("unroll") for(int r=4;r<16;r+=4){a=MX3(a,C0[r],C0[r+1]);b=MX3(b,C0[r+2],C0[r+3]);a=MX3(a,C1[r],C1[r+1]);b=MX3(b,C1[r+2],C1[r+3]);} \
      float rm=__builtin_fmaxf(a,b); { auto rr=__builtin_amdgcn_permlane32_swap(__float_as_uint(rm),__float_as_uint(rm),false,false); rm=__builtin_fmaxf(__uint_as_float(rr[0]),__uint_as_float(rr[1])); } \
      resc=false; \
      if(__builtin_expect(__any(rm>(float)THRL),0)){ const float dl=__builtin_fmaxf(rm,0.f); mhat+=dl; \
        _Pragma("unroll") for(int r=0;r<16;++r){C0[r]-=dl;C1[r]-=dl;} \
        _Pragma("unroll") for(int r=0;r<16;++r)negm[r]=-mhat; asm volatile("":"+v"(negm)); \
        const float f=__builtin_amdgcn_exp2f(-dl); l_reg*=f; if(hi==0)wsf[r32]=f; resc=true; } } \
    SBAR(); \
    GAPB(o[0]=__builtin_amdgcn_mfma_f32_32x32x16_bf16(PAF(0),VFR(0),o[0],0,0,0), C0,0); \
    GAPB(o[1]=__builtin_amdgcn_mfma_f32_32x32x16_bf16(PAF(0),VFR(4),o[1],0,0,0), C0,4); \
    KRD(GL,0); GAPB(o[0]=__builtin_amdgcn_mfma_f32_32x32x16_bf16(PAF(1),VFR(1),o[0],0,0,0), C0,8); \
    KRD(GL,1); GAPB(o[1]=__builtin_amdgcn_mfma_f32_32x32x16_bf16(PAF(1),VFR(5),o[1],0,0,0), C0,12); \
    KRD(GL,2); GAPB(o[0]=__builtin_amdgcn_mfma_f32_32x32x16_bf16(PAF(2),VFR(2),o[0],0,0,0), C1,0); \
    KRD(GL,3); GAPB(o[1]=__builtin_amdgcn_mfma_f32_32x32x16_bf16(PAF(2),VFR(6),o[1],0,0,0), C1,4); \
    GAPB(o[0]=__builtin_amdgcn_mfma_f32_32x32x16_bf16(PAF(3),VFR(3),o[0],0,0,0), C1,8); \
    GAPB(o[1]=__builtin_amdgcn_mfma_f32_32x32x16_bf16(PAF(3),VFR(7),o[1],0,0,0), C1,12); \
    }while(0)
  int t=1;
  #undef CMASK
  #define CMASK(P0,P1,t) do{}while(0)
  for(;t+7<NT;t+=2){
    STEP(pB0,pB1,pA0,pA1,t,true,true,true);     WAIT_BAR(2); RESC(); ROT();
    STEP(pA0,pA1,pB0,pB1,t+1,true,true,true);   WAIT_BAR(2); RESC(); ROT();
  }
  #undef CMASK
  #define CMASK(P0,P1,t) do{int jb_=(t)-(NT-6); if(jb_>=0)cbias(P0,P1,jb_,qrel,hi,lutR);}while(0)
  #define ENDW(tt) do{ if((tt)+3<NT){WAIT_BAR(2);} else if((tt)+2<NT){WAIT_BAR(1);} else {WAIT_BAR(0);} }while(0)
  for(;t+1<NT;t+=2){
    STEP(pB0,pB1,pA0,pA1,t,(t+3<NT),(t+1<NT),(t+1<NT));       ENDW(t);   RESC(); ROT();
    STEP(pA0,pA1,pB0,pB1,t+1,(t+4<NT),(t+2<NT),(t+2<NT));     ENDW(t+1); RESC(); ROT();
  }
  STEP(pB0,pB1,pA0,pA1,NT-1,false,false,false); RESC();
  { float sacc=pB0[0]+pB0[1]; _Pragma("unroll") for(int r=2;r<16;++r)sacc+=pB0[r]; _Pragma("unroll") for(int r=0;r<16;++r)sacc+=pB1[r]; l_reg+=sacc;
    pw0=(u32x4){PKW(pB0,0),PKW(pB0,2),PKW(pB0,4),PKW(pB0,6)};pw1=(u32x4){PKW(pB0,8),PKW(pB0,10),PKW(pB0,12),PKW(pB0,14)};pw2=(u32x4){PKW(pB1,0),PKW(pB1,2),PKW(pB1,4),PKW(pB1,6)};pw3=(u32x4){PKW(pB1,8),PKW(pB1,10),PKW(pB1,12),PKW(pB1,14)};
    SBAR(); pv(o,vb0+sl_cur,PAF(0),PAF(1),PAF(2),PAF(3)); }
  #undef PKW
  #undef PAF
  #undef VFR
  #undef PIN
  #undef MX3
  #undef GAPA
  #undef GAPB
  #undef EX
  #undef VRD
  #undef KRD
  #undef STEP
  #undef ENDW
  {auto rr=__builtin_amdgcn_permlane32_swap(__float_as_uint(l_reg),__float_as_uint(l_reg),false,false);l_reg=__uint_as_float(rr[0])+__uint_as_float(rr[1]);}
  if(hi==0)wsf[32+r32]=l_reg;asm volatile("s_waitcnt lgkmcnt(0)":::"memory");
  float rli[16];
  #pragma unroll
  for(int r=0;r<16;++r)rli[r]=__builtin_amdgcn_rcpf(wsf[32+crow(r,hi)]);
  bf16*Ow=Oc+(rowbase+q0+wid*QBLK)*PO;
  { bf16*stg=(bf16*)(shm+LDS_OST)+wid*2048;
    #pragma unroll
    for(int r=0;r<16;++r){const int orow=crow(r,hi);
      #pragma unroll
      for(int d0=0;d0<2;++d0)stg[orow*64+d0*32+r32]=__float2bfloat16(o[d0][r]*rli[r]);}
    asm volatile("s_waitcnt lgkmcnt(0)":::"memory");
    #pragma unroll
    for(int i=0;i<4;++i){const int row=i*8+(lane>>3),ch=lane&7; const u32x4 v=*(const u32x4*)(stg+row*64+ch*8); ATTN_STORE16(Ow+(long)row*PO+ch*8,v);} }
  asm volatile("s_waitcnt lgkmcnt(0)\n\ts_barrier":::"memory");
  #undef DMA_K
  #undef DMA_V
  #undef CMASK
  #undef START
  #undef RESC
  #undef ROT
}
constexpr int ATTN_LDS_BYTES=LDS_BYTES;
#undef SBAR
#undef WAIT_BAR
}
#define GAS __attribute__((address_space(1)))
#define LAS __attribute__((address_space(3)))
typedef unsigned short bf16;
typedef unsigned v4u __attribute__((ext_vector_type(4)));
typedef float f32x4 __attribute__((ext_vector_type(4)));
typedef short bf16x8 __attribute__((ext_vector_type(8)));
typedef GAS unsigned gu32;
typedef GAS unsigned long long gu64;
#define RLX_AGENT __ATOMIC_RELAXED, __HIP_MEMORY_SCOPE_AGENT
#define LDS_WAIT() asm volatile("s_waitcnt lgkmcnt(0)" ::: "memory")
#define VM_WAIT() asm volatile("s_waitcnt vmcnt(0)" ::: "memory")
__device__ __forceinline__ unsigned long long rt() { return __builtin_amdgcn_s_memrealtime(); }
__device__ __forceinline__ unsigned f2bf(float f) { unsigned u = __builtin_bit_cast(unsigned, f); return (u + 0x7fffu + ((u >> 16) & 1u)) >> 16; }
__device__ __forceinline__ unsigned pk2(float lo, float hi) { return f2bf(lo) | (f2bf(hi) << 16); }

#define XB_TMO      128
#define XB_XCNT(j)  (256  + 64 * (j))
#define XB_XSUB(j)  (1280 + 64 * (j))
#define XB_XGEN(j)  (2304 + 64 * (j))
#define XB_TOP      3328
#define XB_TOPGEN   3392
#define XCD_BAR_WORDS 3456
#define XB_SPIN_CAP (1u << 18)

__device__ __forceinline__ unsigned xb_ld(unsigned* p)              { return __hip_atomic_load(p, __ATOMIC_RELAXED, __HIP_MEMORY_SCOPE_AGENT); }
__device__ __forceinline__ unsigned xb_add(unsigned* p, unsigned v) { return __hip_atomic_fetch_add(p, v, __ATOMIC_RELAXED, __HIP_MEMORY_SCOPE_AGENT); }
__device__ __forceinline__ unsigned xb_xcc_id() { return (unsigned)__builtin_amdgcn_s_getreg((3 << 11) | 20) & 0xFu; }
#define XB_SPIN(cond, bar) do { unsigned _sp = 0; while (cond) { __builtin_amdgcn_s_sleep(1); \
    if ((++_sp & 255u) == 0u) { if (xb_ld(&(bar)[XB_TMO])) break; if (_sp > XB_SPIN_CAP) { atomicAdd(&(bar)[XB_TMO], 1u); break; } } } } while (0)

struct XcdBarrier {
    unsigned* bar; unsigned x;
    volatile LAS unsigned* st;
};

__device__ __forceinline__ XcdBarrier xcd_barrier_post(unsigned* bar, volatile LAS unsigned* st) {
    XcdBarrier b; b.bar = bar; b.x = xb_xcc_id(); b.st = st;
    if (threadIdx.x == 0) (void)xb_add(&bar[XB_XCNT(b.x)], 1u);
    return b;
}
__device__ __forceinline__ void xcd_barrier_complete(unsigned* bar, unsigned x, unsigned& nloc, unsigned& nx) {
    const unsigned G = gridDim.x * gridDim.y * gridDim.z;
    unsigned sum, cnt, mine, sp = 0u;
    for (;;) {
        sum = 0u; cnt = 0u; mine = 0u;
#pragma unroll
        for (unsigned j = 0; j < 16; ++j) { const unsigned c = xb_ld(&bar[XB_XCNT(j)]); sum += c; cnt += (c > 0u) ? 1u : 0u; mine = (j == x) ? c : mine; }
        if (sum == G) break;
        __builtin_amdgcn_s_sleep(1);
        if ((++sp & 255u) == 0u) { if (xb_ld(&bar[XB_TMO])) break; if (sp > XB_SPIN_CAP) { atomicAdd(&bar[XB_TMO], 1u); break; } }
    }
    nloc = mine > 0u ? mine : 1u; nx = cnt > 0u ? cnt : 1u;
}

__device__ __forceinline__ void xcd_barrier(const XcdBarrier& b) {
    asm volatile("s_waitcnt vmcnt(0)" ::: "memory");
    __syncthreads();
    if (threadIdx.x == 0) {
        unsigned* bar = b.bar;
        __builtin_amdgcn_s_waitcnt(0);
        unsigned nloc = b.st[0], nx = b.st[1];
        if (nloc == 0u) { xcd_barrier_complete(bar, b.x, nloc, nx); b.st[0] = nloc; b.st[1] = nx; }
        const unsigned old = xb_add(&bar[XB_XSUB(b.x)], 1u);
        const unsigned gen = old / nloc;
        if (old + 1u == (gen + 1u) * nloc) {
            __builtin_amdgcn_fence(__ATOMIC_RELEASE, "agent");
            asm volatile("s_waitcnt vmcnt(0)" ::: "memory");
            const unsigned og = xb_add(&bar[XB_TOP], 1u);
            const unsigned tg = og / nx;
            if (og + 1u == (tg + 1u) * nx) xb_add(&bar[XB_TOPGEN], 1u);
            else XB_SPIN(xb_ld(&bar[XB_TOPGEN]) == tg, bar);
            __builtin_amdgcn_fence(__ATOMIC_ACQUIRE, "agent");
            xb_add(&bar[XB_XGEN(b.x)], 1u);
            asm volatile("s_waitcnt vmcnt(0)" ::: "memory");
        } else {
            XB_SPIN(xb_ld(&bar[XB_XGEN(b.x)]) == gen, bar);
            __builtin_amdgcn_fence(__ATOMIC_ACQUIRE, "agent");
            asm volatile("s_waitcnt vmcnt(0)" ::: "memory");
        }
    }
    __syncthreads();
}
constexpr int NWAVES = 8;
constexpr int DM = 1024, NB = 8, SEQ = 2048, MP = NB * SEQ, DECB = 128, DECS = 4, MS = DECB * DECS, M = MP + MS;
constexpr int RH = 8, RW = 512, RCOLS = 1792, PCOLS = 3328, DFF = 2816, NPG = 16, PAGE = 128;
constexpr float NORM_EPS = 1e-6f, SUBLN_EPS = 1e-5f, GN_EPS = 64e-5f, LAM_INIT = 0.2f;
constexpr float LOG2E = 1.4426950408889634f;
constexpr float QSCALE = 0.125f * LOG2E;
#ifndef MK_PER_PHASE
#define MK_PER_PHASE 0
#endif
constexpr int NPHASE = 13;
constexpr size_t OUT_Y = 0, OUT_KP = (size_t)M * DM, OUT_VP = OUT_KP + (size_t)MP * 512, OUT_KS = OUT_VP + (size_t)MP * 512, OUT_VS = OUT_KS + (size_t)MS * 512,
                 OUT_WP = OUT_VS + (size_t)MS * 512, OUT_WS = OUT_WP + (size_t)NB * RH * 4096, OUT_SP = OUT_WS + (size_t)DECB * RH * 4096, OUT_SS = OUT_SP + (size_t)NB * RCOLS, OUT_END = OUT_SS + (size_t)DECB * RCOLS;
constexpr size_t MiB = 1u << 20;
constexpr size_t WS_CTL = 0, CTL_ZERO_BYTES = 1 * MiB, WS_ZERO = 512 * 1024;
constexpr size_t WS_FF1IN = 2 * MiB, WS_FF1OUT = 14 * MiB, WS_FF2IN = 20 * MiB, WS_FF2OUT = 32 * MiB, WS_WIN = 38 * MiB, WS_WOUT = 45 * MiB, WS_LORA = 47 * MiB;
constexpr size_t WS_XN = 48 * MiB, WS_H = 82 * MiB, WS_F = 174 * MiB, WS_HRES = 240 * MiB, WS_QKV = 306 * MiB, WS_PR = 356 * MiB, WS_SI = 472 * MiB, WS_G = 670 * MiB,
                 WS_Y = 703 * MiB, WS_O = 736 * MiB, WS_XM = 768 * MiB, WS_BONUS = 801 * MiB, WS_END = 802 * MiB;
static_assert(WS_FF1IN + (size_t)2 * DFF * DM * 2 <= WS_FF1OUT && WS_FF1OUT + (size_t)DM * DFF * 2 <= WS_FF2IN && WS_FF2IN + (size_t)2 * DFF * DM * 2 <= WS_FF2OUT && WS_FF2OUT + (size_t)DM * DFF * 2 <= WS_WIN, "ws map 1");
static_assert(WS_WIN + (size_t)PCOLS * DM * 2 <= WS_WOUT && WS_WOUT + (size_t)DM * DM * 2 <= WS_LORA && WS_LORA + 256 * 1024 <= WS_XN && WS_XN + (size_t)M * DM * 2 <= WS_H && WS_H + (size_t)M * DFF * 2 <= WS_F, "ws map 2");
static_assert(WS_F + (size_t)M * DM * 4 <= WS_HRES && WS_HRES + (size_t)M * DM * 4 <= WS_QKV && WS_QKV + (size_t)M * 1536 * 2 <= WS_PR && WS_PR + (size_t)M * RCOLS * 4 <= WS_SI && WS_SI + (size_t)M * RH * 384 * 4 <= WS_G, "ws map 3");
static_assert(WS_G + (size_t)M * 512 * 4 <= WS_Y && WS_Y + (size_t)M * 512 * 4 <= WS_O && WS_O + (size_t)MP * 1024 * 2 <= WS_XM && WS_XM + (size_t)M * DM * 2 <= WS_BONUS && WS_BONUS + (size_t)M * RH * 4 <= WS_END, "ws map 4");
constexpr size_t SI_S0 = (size_t)NB * RH * SEQ * 384;
constexpr int CW_TMO = 0, CW_CODE = 1, CW_BAR = 4096;
static_assert((CW_BAR + XCD_BAR_WORDS) * 4 <= (int)WS_ZERO, "CTL words");
constexpr int RING_OFF = 0, RING_BYTES = 131072, LDSCTL_OFF = RING_BYTES, MISC_OFF = LDSCTL_OFF + 320, LDS_BYTES = 147456;
constexpr int LUTR_OFF = LDSCTL_OFF + 512;
constexpr int LUTD_OFF = LUTR_OFF + 4 * 640 * 4;
static_assert(attn_body::ATTN_LDS_BYTES <= RING_BYTES && LUTD_OFF + 4 * 128 * 4 <= LDS_BYTES && MISC_OFF + 128 <= LUTR_OFF, "LDS map");

struct Frame {
    LAS unsigned char* lds; volatile LAS unsigned* MISC; gu32* ctl;
    int tid, lane, wave, vcu, G;
    const float *x_p, *x_s, *cache_k, *cache_v; const int* page_table; const float *state_wkv, *state_shift, *gains, *ff1_in, *ff1_out, *ff2_in, *ff2_out, *w_in, *w_out, *rel_tab;
    const float *lq1, *lk1, *lq2, *lk2, *subln, *mu, *w0, *w2, *a0, *a2, *g2, *kkp, *ka, *rk, *gn_w, *gn_b;
    float* out;
    unsigned char* ws;
};
typedef float f32x2 __attribute__((ext_vector_type(2)));
__device__ __forceinline__ float wave_sum(float v) {
#pragma unroll
    for (int o = 1; o < 64; o <<= 1) v += __shfl_xor(v, o);
    return v;
}
template <int CTRL> __device__ __forceinline__ float dpp_mov(float x) { return __builtin_bit_cast(float, __builtin_amdgcn_update_dpp(0, __builtin_bit_cast(int, x), CTRL, 0xF, 0xF, true)); }
__device__ __forceinline__ float red16(float x) {
    x += dpp_mov<0xB1>(x); x += dpp_mov<0x4E>(x); x += dpp_mov<0x141>(x); x += dpp_mov<0x140>(x); return x; }
__device__ __forceinline__ float red8(float x) { x += dpp_mov<0xB1>(x); x += dpp_mov<0x4E>(x); x += dpp_mov<0x141>(x); return x; }
__device__ __forceinline__ float xsum16(float x) { auto rr = __builtin_amdgcn_permlane16_swap(__float_as_uint(x), __float_as_uint(x), false, false); return __uint_as_float(rr[0]) + __uint_as_float(rr[1]); }
__device__ __forceinline__ float xsum32(float x) { auto rr = __builtin_amdgcn_permlane32_swap(__float_as_uint(x), __float_as_uint(x), false, false); return __uint_as_float(rr[0]) + __uint_as_float(rr[1]); }
__device__ __forceinline__ float xmax16(float x) { auto rr = __builtin_amdgcn_permlane16_swap(__float_as_uint(x), __float_as_uint(x), false, false); return fmaxf(__uint_as_float(rr[0]), __uint_as_float(rr[1])); }
__device__ __forceinline__ float xmax32(float x) { auto rr = __builtin_amdgcn_permlane32_swap(__float_as_uint(x), __float_as_uint(x), false, false); return fmaxf(__uint_as_float(rr[0]), __uint_as_float(rr[1])); }
__device__ __forceinline__ float red32(float x) { return xsum16(red16(x)); }
__device__ __forceinline__ bf16x8 pack8(const float* v) { v4u w; w.x = pg8::cvt_pk_bf16(v[0], v[1]); w.y = pg8::cvt_pk_bf16(v[2], v[3]); w.z = pg8::cvt_pk_bf16(v[4], v[5]); w.w = pg8::cvt_pk_bf16(v[6], v[7]); return __builtin_bit_cast(bf16x8, w); }
__device__ __forceinline__ float sigm(float x) { return __builtin_amdgcn_rcpf(1.f + __builtin_amdgcn_exp2f(-LOG2E * x)); }
__device__ __forceinline__ float tanh_f(float x) { return 1.f - 2.f * __builtin_amdgcn_rcpf(1.f + __builtin_amdgcn_exp2f(2.f * LOG2E * x)); }
__device__ __forceinline__ float compute_lam(const Frame& F) {
    const float d1 = wave_sum(F.lq1[F.lane] * F.lk1[F.lane]), d2 = wave_sum(F.lq2[F.lane] * F.lk2[F.lane]);
    return __expf(d1) - __expf(d2) + LAM_INIT;
}
__device__ __forceinline__ float bias_delta(const float* tab, int n, int h) {
    int bucket;
    if (n < 16) bucket = n;
    else { const int lg = 16 + (int)(logf((float)n / 16.0f) / 2.0794415416798357f * 16.0f); bucket = lg < 31 ? lg : 31; }
    return (tab[bucket * 4 + h] - tab[31 * 4 + h]) * LOG2E;
}

__device__ __forceinline__ void p0_transpose_item(const float* W, int K, int N, bf16* WT, int dst_row0, LAS float* scr, int k0, int n0, int lane) {
#pragma unroll 8
    for (int i = 0; i < 32; ++i) { const int kk = 2 * i + (lane >> 5); scr[kk * 33 + (lane & 31)] = W[(size_t)(k0 + kk) * N + n0 + (lane & 31)]; }
    LDS_WAIT(); asm volatile("" ::: "memory");
    const int c = lane & 7;
#pragma unroll
    for (int j = 0; j < 4; ++j) { const int n = (lane >> 3) + 8 * j; const LAS float* s = scr + (8 * c) * 33 + n;
        v4u o; o.x = pk2(s[0 * 33], s[1 * 33]); o.y = pk2(s[2 * 33], s[3 * 33]); o.z = pk2(s[4 * 33], s[5 * 33]); o.w = pk2(s[6 * 33], s[7 * 33]);
        *(GAS v4u*)(WT + (size_t)(dst_row0 + n) * K + k0 + 8 * c) = o; }
    LDS_WAIT(); asm volatile("" ::: "memory");
}
__device__ __forceinline__ const float* xrow_ptr(const Frame& F, int m) { return m < MP ? F.x_p + (size_t)m * DM : F.x_s + (size_t)(m - MP) * DM; }
__device__ __forceinline__ void p0_prologue(Frame& F) {
    LAS float* scr = (LAS float*)(F.lds + RING_OFF + F.wave * 16384);
    const int gw = F.vcu * NWAVES + F.wave, NGW = F.G * NWAVES;
    constexpr int I_FI = (DM / 64) * (2 * DFF / 32), I_FO = (DFF / 64) * (DM / 32), I_WI = (DM / 64) * (PCOLS / 32), I_WO = (DM / 64) * (DM / 32), I_L64 = 16, I_L128 = 32;
    constexpr int NITEMS = 2 * I_FI + 2 * I_FO + I_WI + I_WO + 2 * I_L64 + I_L128;
    for (int it = gw; it < NITEMS; it += NGW) {
        int r = it;
        if (r < 2 * I_FI) { const bool second = r >= I_FI; if (second) r -= I_FI; const int nblk = 2 * DFF / 32, kb = r / nblk, nb = r % nblk, n0 = 32 * nb;
            const int j = n0 < DFF ? n0 : n0 - DFF, drow = 256 * (j / 128) + (n0 < DFF ? 0 : 128) + (j % 128);
            p0_transpose_item(second ? F.ff2_in : F.ff1_in, DM, 2 * DFF, second ? ((bf16*)(F.ws + WS_FF2IN)) : ((bf16*)(F.ws + WS_FF1IN)), drow, scr, 64 * kb, n0, F.lane); continue; }
        r -= 2 * I_FI;
        if (r < 2 * I_FO) { const bool second = r >= I_FO; if (second) r -= I_FO; const int nblk = DM / 32, kb = r / nblk, nb = r % nblk;
            p0_transpose_item(second ? F.ff2_out : F.ff1_out, DFF, DM, second ? ((bf16*)(F.ws + WS_FF2OUT)) : ((bf16*)(F.ws + WS_FF1OUT)), 32 * nb, scr, 64 * kb, 32 * nb, F.lane); continue; }
        r -= 2 * I_FO;
        if (r < I_WI) { const int nblk = PCOLS / 32, kb = r / nblk, nb = r % nblk; p0_transpose_item(F.w_in, DM, PCOLS, ((bf16*)(F.ws + WS_WIN)), 32 * nb, scr, 64 * kb, 32 * nb, F.lane); continue; }
        r -= I_WI;
        if (r < I_WO) { const int nblk = DM / 32, kb = r / nblk, nb = r % nblk; p0_transpose_item(F.w_out, DM, DM, ((bf16*)(F.ws + WS_WOUT)), 32 * nb, scr, 64 * kb, 32 * nb, F.lane); continue; }
        r -= I_WO;
        if (r < I_L64) { p0_transpose_item(F.w2, 64, RW, ((bf16*)(F.ws + WS_LORA)), 32 * r, scr, 0, 32 * r, F.lane); continue; }
        r -= I_L64;
        if (r < I_L64) { p0_transpose_item(F.a2, 64, RW, ((bf16*)(F.ws + WS_LORA) + 512 * 64), 32 * r, scr, 0, 32 * r, F.lane); continue; }
        r -= I_L64;
        { const int kb = r / 16, nb = r % 16; p0_transpose_item(F.g2, 128, RW, ((bf16*)(F.ws + WS_LORA) + 2 * 512 * 64), 32 * nb, scr, 64 * kb, 32 * nb, F.lane); }
    }
    const GAS f32x4* gp = (const GAS f32x4*)(F.gains) + F.lane;
    for (int m = gw; m < M; m += NGW) {
        const GAS f32x4* xr = (const GAS f32x4*)xrow_ptr(F, m) + F.lane;
        f32x4 v[4]; float s = 0.f;
#pragma unroll
        for (int j = 0; j < 4; ++j) { v[j] = xr[64 * j]; s += (v[j].x * v[j].x + v[j].y * v[j].y) + (v[j].z * v[j].z + v[j].w * v[j].w); }
        const float rstd = 1.0f / sqrtf(wave_sum(s) * (1.f / DM) + NORM_EPS);
        GAS unsigned long long* o8 = (GAS unsigned long long*)(((bf16*)(F.ws + WS_XN)) + (size_t)m * DM) + F.lane;
#pragma unroll
        for (int j = 0; j < 4; ++j) { const f32x4 g = gp[64 * j]; o8[64 * j] = (unsigned long long)pk2(v[j].x * rstd * g.x, v[j].y * rstd * g.y) | ((unsigned long long)pk2(v[j].z * rstd * g.z, v[j].w * rstd * g.w) << 32); }
    }
}
template <bool HAS_XN> __device__ __forceinline__ void rowwise_phase(Frame& F, const float* base_p, const float* base_s, float* outp, const float* ga, float scale, const float* gb) {
    const int gw = F.vcu * NWAVES + F.wave, NGW = F.G * NWAVES;
    const GAS f32x4* gap = (const GAS f32x4*)ga + F.lane; const GAS f32x4* gbp = (const GAS f32x4*)gb + F.lane;
    for (int m = gw; m < M; m += NGW) {
        const GAS f32x4* fr = (const GAS f32x4*)(((float*)(F.ws + WS_F)) + (size_t)m * DM) + F.lane;
        const GAS f32x4* br = (const GAS f32x4*)(m < MP ? base_p + (size_t)m * DM : base_s + (size_t)(m - MP) * DM) + F.lane;
        f32x4 f[4], bsv[4]; float s = 0.f;
#pragma unroll
        for (int j = 0; j < 4; ++j) { f[j] = fr[64 * j]; bsv[j] = br[64 * j]; s += (f[j].x * f[j].x + f[j].y * f[j].y) + (f[j].z * f[j].z + f[j].w * f[j].w); }
        const float rstd = scale / sqrtf(wave_sum(s) * (1.f / DM) + NORM_EPS);
        GAS f32x4* orow = (GAS f32x4*)(outp + (size_t)m * DM) + F.lane; float s2 = 0.f;
#pragma unroll
        for (int j = 0; j < 4; ++j) { const f32x4 g = gap[64 * j]; f32x4 o = bsv[j] + f[j] * rstd * g; orow[64 * j] = o; f[j] = o; s2 += (o.x * o.x + o.y * o.y) + (o.z * o.z + o.w * o.w); }
        if (HAS_XN) {
            const float r2 = 1.0f / sqrtf(wave_sum(s2) * (1.f / DM) + NORM_EPS);
            GAS unsigned long long* o8 = (GAS unsigned long long*)(((bf16*)(F.ws + WS_XN)) + (size_t)m * DM) + F.lane;
#pragma unroll
            for (int j = 0; j < 4; ++j) { const f32x4 g = gbp[64 * j]; o8[64 * j] = (unsigned long long)pk2(f[j].x * r2 * g.x, f[j].y * r2 * g.y) | ((unsigned long long)pk2(f[j].z * r2 * g.z, f[j].w * r2 * g.w) << 32); }
        }
    }
}
__device__ __forceinline__ f32x4 lerp4(const float* cur, const float* prev, const float* mu, int c) {
    const f32x4 a = *(const GAS f32x4*)(cur + c), b = *(const GAS f32x4*)(prev + c), m = *(const GAS f32x4*)(mu + c); return a + (b - a) * m; }
__device__ __forceinline__ void prep_phase(Frame& F) {
    const int lane = F.lane, fr = lane & 15, fq = lane >> 4, h = F.wave;
    const float* PRb = (const float*)(F.ws + WS_PR);
    for (int tile = F.vcu; tile < M / 16; tile += F.G) {
        const int m = tile * 16 + fr; int t, b; const float* prevp; size_t sioff;
        if (m < MP) { t = m & (SEQ - 1); b = m >> 11; prevp = t ? PRb + (size_t)(m - 1) * RCOLS : (const float*)(F.ws + WS_ZERO); sioff = ((size_t)(b * RH + h) * SEQ + t) * 384; }
        else { const int ms = m - MP; t = ms & 3; b = ms >> 2; prevp = t ? PRb + (size_t)(m - 1) * RCOLS : F.state_shift + (size_t)b * RCOLS; sioff = SI_S0 + ((size_t)(b * RH + h) * DECS + t) * 384; }
        const float* curp = PRb + (size_t)m * RCOLS;
        bf16x8 xw[2], xa[2], xg[4];
#pragma unroll
        for (int s = 0; s < 2; ++s) { const int c = 1536 + 32 * s + 8 * fq; const f32x4 v0 = lerp4(curp, prevp, F.mu, c), v1 = lerp4(curp, prevp, F.mu, c + 4);
            float e[8] = {tanh_f(v0[0]), tanh_f(v0[1]), tanh_f(v0[2]), tanh_f(v0[3]), tanh_f(v1[0]), tanh_f(v1[1]), tanh_f(v1[2]), tanh_f(v1[3])}; xw[s] = pack8(e); }
        asm volatile("" ::: "memory");
#pragma unroll
        for (int s = 0; s < 2; ++s) { const int c = 1600 + 32 * s + 8 * fq; const f32x4 v0 = lerp4(curp, prevp, F.mu, c), v1 = lerp4(curp, prevp, F.mu, c + 4);
            float e[8] = {v0[0], v0[1], v0[2], v0[3], v1[0], v1[1], v1[2], v1[3]}; xa[s] = pack8(e); }
        asm volatile("" ::: "memory");
#pragma unroll
        for (int s = 0; s < 4; ++s) { const int c = 1664 + 32 * s + 8 * fq; const f32x4 v0 = lerp4(curp, prevp, F.mu, c), v1 = lerp4(curp, prevp, F.mu, c + 4);
            float e[8] = {sigm(v0[0]), sigm(v0[1]), sigm(v0[2]), sigm(v0[3]), sigm(v1[0]), sigm(v1[1]), sigm(v1[2]), sigm(v1[3])}; xg[s] = pack8(e);
            if (s == 1) asm volatile("" ::: "memory"); }
        asm volatile("" ::: "memory");
        float ssq = 0.f;
#pragma unroll
        for (int nb = 0; nb < 4; ++nb) { const int c = 64 * h + 16 * nb + 4 * fq; const f32x4 k4 = lerp4(curp, prevp, F.mu, 512 + c), kkp = *(const GAS f32x4*)(F.kkp + c); const f32x4 kk = k4 * kkp;
            ssq += (kk[0] * kk[0] + kk[1] * kk[1]) + (kk[2] * kk[2] + kk[3] * kk[3]); }
        ssq = xsum32(xsum16(ssq));
        const float rn = 1.0f / fmaxf(sqrtf(ssq), 1e-12f); float bon = 0.f;
        float* sip = (float*)(F.ws + WS_SI) + sioff;
        asm volatile("" ::: "memory");
#pragma unroll 1
        for (int nb = 0; nb < 4; ++nb) {
            const int cl = 16 * nb + 4 * fq, c = 64 * h + cl;
            f32x4 aw = {0.f, 0.f, 0.f, 0.f}, aa = aw, ag = aw;
            const bf16* wrow = (const bf16*)(F.ws + WS_LORA) + (size_t)(64 * h + 16 * nb + fr) * 64 + 8 * fq; const bf16* arow = wrow + 512 * 64; const bf16* grow = (const bf16*)(F.ws + WS_LORA) + 2 * 512 * 64 + (size_t)(64 * h + 16 * nb + fr) * 128 + 8 * fq;
#pragma unroll
            for (int s = 0; s < 2; ++s) { aw = __builtin_amdgcn_mfma_f32_16x16x32_bf16(*(const GAS bf16x8*)(wrow + 32 * s), xw[s], aw, 0, 0, 0); aa = __builtin_amdgcn_mfma_f32_16x16x32_bf16(*(const GAS bf16x8*)(arow + 32 * s), xa[s], aa, 0, 0, 0); }
#pragma unroll
            for (int s = 0; s < 4; ++s) ag = __builtin_amdgcn_mfma_f32_16x16x32_bf16(*(const GAS bf16x8*)(grow + 32 * s), xg[s], ag, 0, 0, 0);
            const f32x4 r4 = lerp4(curp, prevp, F.mu, c), k4 = lerp4(curp, prevp, F.mu, 512 + c), v4 = lerp4(curp, prevp, F.mu, 1024 + c);
            const f32x4 w0 = *(const GAS f32x4*)(F.w0 + c), a0 = *(const GAS f32x4*)(F.a0 + c), kkp = *(const GAS f32x4*)(F.kkp + c), ka = *(const GAS f32x4*)(F.ka + c), rk = *(const GAS f32x4*)(F.rk + c);
            f32x4 dec, a4;
#pragma unroll
            for (int i = 0; i < 4; ++i) { const float z = -(w0[i] + aw[i]);
                const float sp = fmaxf(z, 0.f) + __logf(1.f + __expf(-fabsf(z))); const float lw = -sp - 0.5f; dec[i] = __expf(-__expf(lw)); a4[i] = sigm(a0[i] + aa[i]); }
            const f32x4 kkn = (k4 * kkp) * rn; const f32x4 krp = k4 * (1.f + (a4 - 1.f) * ka); const f32x4 bb = kkn * a4; const f32x4 pr = r4 * krp * rk;
            bon += (pr[0] + pr[1]) + (pr[2] + pr[3]);
            *(GAS f32x4*)(sip + 0 * 64 + cl) = r4; *(GAS f32x4*)(sip + 1 * 64 + cl) = dec; *(GAS f32x4*)(sip + 2 * 64 + cl) = krp; *(GAS f32x4*)(sip + 3 * 64 + cl) = -kkn; *(GAS f32x4*)(sip + 4 * 64 + cl) = bb; *(GAS f32x4*)(sip + 5 * 64 + cl) = v4;
            *(GAS f32x4*)((float*)(F.ws + WS_G) + (size_t)m * 512 + c) = ag;
        }
        bon = xsum32(xsum16(bon));
        if (fq == 0) ((float*)(F.ws + WS_BONUS))[(size_t)m * RH + h] = bon;
    }
}
__device__ __forceinline__ void scan_sample(Frame& F) {
    const int gw = F.vcu * NWAVES + F.wave, NGW = F.G * NWAVES, kp = F.lane & 31, hr = F.lane >> 5;
    for (int task = gw; task < DECB * RH * 32; task += NGW) {
        const int bh = task >> 5, vrow = 2 * (task & 31) + hr;
        const float* src = ((float*)(F.ws + WS_SI)) + SI_S0 + (size_t)bh * DECS * 384;
        f32x2 st = *(const GAS f32x2*)(F.state_wkv + ((size_t)bh * 64 + vrow) * 64 + 2 * kp);
        f32x2 r2[DECS], w2[DECS], k2[DECS], n2[DECS], b2[DECS]; float vv[DECS];
#pragma unroll
        for (int t = 0; t < DECS; ++t) { const float* sp = src + t * 384 + 2 * kp; r2[t] = *(const GAS f32x2*)(sp); w2[t] = *(const GAS f32x2*)(sp + 64); k2[t] = *(const GAS f32x2*)(sp + 128);
            n2[t] = *(const GAS f32x2*)(sp + 192); b2[t] = *(const GAS f32x2*)(sp + 256); vv[t] = src[t * 384 + 320 + vrow]; }
#pragma unroll
        for (int t = 0; t < DECS; ++t) {
            const float sa = red32(st.x * n2[t].x + st.y * n2[t].y);
            st.x = st.x * w2[t].x + sa * b2[t].x + vv[t] * k2[t].x; st.y = st.y * w2[t].y + sa * b2[t].y + vv[t] * k2[t].y;
            const float y = red32(st.x * r2[t].x + st.y * r2[t].y);
            if (kp == 0) ((float*)(F.ws + WS_Y))[(size_t)(MP + (bh >> 3) * DECS + t) * 512 + (bh & 7) * 64 + vrow] = y;
        }
        *(GAS f32x2*)(F.out + OUT_WS + ((size_t)bh * 64 + vrow) * 64 + 2 * kp) = st;
    }
}
__device__ __forceinline__ void scan_prompt(Frame& F) {
    constexpr int TC = 32, CH = TC * 384;
    LAS float* buf = (LAS float*)(F.lds + RING_OFF); LAS float* yst = buf + 2 * CH;
    const int kp = F.lane & 31, hr = F.lane >> 5, tid = F.tid;
    for (int item = F.vcu; item < NB * RH * 4; item += F.G) {
        const int bh = item >> 2, rg = item & 3, vloc = F.wave * 2 + hr, vrow = rg * 16 + vloc;
        const float* src = ((float*)(F.ws + WS_SI)) + (size_t)bh * SEQ * 384;
        float s0 = 0.f, s1 = 0.f;
#define SCAN_STAGE(cc, bb) do { _Pragma("unroll") for (int _p = 0; _p < 6; ++_p) { const int pc = F.wave + 8 * _p; \
            __builtin_amdgcn_global_load_lds((const unsigned*)(src + (size_t)(cc) * CH + pc * 256 + F.lane * 4), (LAS unsigned*)(buf + (bb) * CH + pc * 256), 16, 0, 0); } } while (0)
        SCAN_STAGE(0, 0);
        __syncthreads();
        for (int c = 0; c < SEQ / TC; ++c) {
            const int cur = c & 1;
            if (c + 1 < SEQ / TC) SCAN_STAGE(c + 1, cur ^ 1);
            const LAS float* bp = buf + cur * CH;
#pragma unroll 4
            for (int t = 0; t < TC; ++t) {
                const LAS float* sp = bp + t * 384 + 2 * kp;
                const f32x2 r2 = *(const LAS f32x2*)(sp), w2 = *(const LAS f32x2*)(sp + 64), k2 = *(const LAS f32x2*)(sp + 128), n2 = *(const LAS f32x2*)(sp + 192), b2 = *(const LAS f32x2*)(sp + 256);
                const float vv = bp[t * 384 + 320 + vrow];
                const float sa = red32(s0 * n2.x + s1 * n2.y);
                s0 = s0 * w2.x + sa * b2.x + vv * k2.x; s1 = s1 * w2.y + sa * b2.y + vv * k2.y;
                const float y = red32(s0 * r2.x + s1 * r2.y);
                if (kp == 0) yst[t * 16 + vloc] = y;
            }
            __syncthreads();
            { const int t = tid >> 4, v = tid & 15; ((float*)(F.ws + WS_Y))[(size_t)((bh >> 3) * SEQ + c * TC + t) * 512 + (bh & 7) * 64 + rg * 16 + v] = yst[tid]; }
            __syncthreads();
        }
#undef SCAN_STAGE
        *(GAS f32x2*)(F.out + OUT_WP + ((size_t)bh * 64 + vrow) * 64 + 2 * kp) = (f32x2){s0, s1};
    }
}
typedef float f32x4v __attribute__((ext_vector_type(4)));
__device__ __forceinline__ void decode_attn(Frame& F, float lam) {
    const int lane = F.lane, j = lane & 15, grp = lane >> 4, w = F.wave, tid = F.tid;
    const LAS float* lutD = (const LAS float*)(F.lds + LUTD_OFF);
    LAS float* cmb = (LAS float*)(F.lds + RING_OFF);
    constexpr int CW = 32 + 2048;
    LAS float* red = cmb + 8 * CW;
    const int tq = j & 3, mp = (j >> 2) & 1;
    for (int unit = F.vcu; unit < DECB * 4; unit += F.G) {
        const int b = unit >> 2, h = unit & 3;
        bf16x8 qf[4];
#pragma unroll
        for (int s = 0; s < 4; ++s) { v4u z = {0u, 0u, 0u, 0u};
            if (j < 8 && (s >> 1) == mp) z = *(const GAS v4u*)(((bf16*)(F.ws + WS_QKV)) + (size_t)(MP + DECS * b + tq) * 1536 + (h * 2 + mp) * 64 + 32 * (s & 1) + 8 * grp);
            qf[s] = __builtin_bit_cast(bf16x8, z); }
        float mrow = -1e30f, lsum = 0.f; f32x4 o[8];
#pragma unroll
        for (int i = 0; i < 8; ++i) o[i] = (f32x4){0.f, 0.f, 0.f, 0.f};
        const int* pt = F.page_table + b * NPG;
        for (int it = 0; it <= 8; ++it) {
            const bool tail = (it == 8);
            if (tail && w != 0) break;
            const int p0 = 256 * w + 32 * it;
            f32x4 sT[2]; const float* vbase; size_t vstride;
            if (!tail) {
                const int page = pt[p0 >> 7]; const size_t tok0 = (size_t)page * PAGE + (p0 & 127);
#pragma unroll
                for (int T = 0; T < 2; ++T) { const float* kp_ = F.cache_k + ((tok0 + 16 * T + j) * 4 + h) * 128 + 8 * grp; f32x4 acc = {0.f, 0.f, 0.f, 0.f};
#pragma unroll
                    for (int s = 0; s < 4; ++s) { const f32x4 a0 = *(const GAS f32x4*)(kp_ + 32 * s), a1 = *(const GAS f32x4*)(kp_ + 32 * s + 4);
                        float e[8] = {a0[0], a0[1], a0[2], a0[3], a1[0], a1[1], a1[2], a1[3]}; acc = __builtin_amdgcn_mfma_f32_16x16x32_bf16(pack8(e), qf[s], acc, 0, 0, 0); }
                    sT[T] = acc; }
                if (p0 >= SEQ - 128) {
#pragma unroll
                    for (int T = 0; T < 2; ++T)
#pragma unroll
                        for (int r = 0; r < 4; ++r) { int n = (SEQ + tq) - (p0 + 16 * T + 4 * grp + r); n = n > 127 ? 127 : n; sT[T][r] += lutD[h * 128 + n]; } }
                vbase = F.cache_v + (tok0 * 4 + h) * 128; vstride = 512;
            } else {
                const float* kp_ = F.out + OUT_KS + ((size_t)(DECS * b + (j & 3)) * 512) + h * 128 + 8 * grp; f32x4 acc = {0.f, 0.f, 0.f, 0.f};
#pragma unroll
                for (int s = 0; s < 4; ++s) { f32x4 a0 = {0.f, 0.f, 0.f, 0.f}, a1 = a0; if (j < 4) { a0 = *(const GAS f32x4*)(kp_ + 32 * s); a1 = *(const GAS f32x4*)(kp_ + 32 * s + 4); }
                    float e[8] = {a0[0], a0[1], a0[2], a0[3], a1[0], a1[1], a1[2], a1[3]}; acc = __builtin_amdgcn_mfma_f32_16x16x32_bf16(pack8(e), qf[s], acc, 0, 0, 0); }
#pragma unroll
                for (int r = 0; r < 4; ++r) { const int key = 4 * grp + r; const bool ok = key < 4 && key <= tq; const int n = ok ? tq - key : 0; acc[r] = ok ? acc[r] + lutD[h * 128 + n] : -INFINITY; }
                sT[0] = acc; sT[1] = (f32x4){-INFINITY, -INFINITY, -INFINITY, -INFINITY};
                vbase = F.out + OUT_VS + (size_t)(DECS * b) * 512 + h * 128; vstride = 512;
            }
            float tmax = fmaxf(fmaxf(fmaxf(sT[0][0], sT[0][1]), fmaxf(sT[0][2], sT[0][3])), fmaxf(fmaxf(sT[1][0], sT[1][1]), fmaxf(sT[1][2], sT[1][3])));
            tmax = xmax32(xmax16(tmax));
            const float mnew = fmaxf(mrow, tmax), alpha = __builtin_amdgcn_exp2f(mrow - mnew); mrow = mnew;
            float p[8]; float ps = 0.f;
#pragma unroll
            for (int r = 0; r < 4; ++r) { p[r] = __builtin_amdgcn_exp2f(sT[0][r] - mnew); p[4 + r] = __builtin_amdgcn_exp2f(sT[1][r] - mnew); ps += p[r] + p[4 + r]; }
            lsum = lsum * alpha + ps;
            const bf16x8 pf = pack8(p);
#pragma unroll
            for (int blk = 0; blk < 8; ++blk) { float v8[8];
#pragma unroll
                for (int e = 0; e < 8; ++e) { const int key = (e < 4) ? 4 * grp + e : 16 + 4 * grp + (e - 4);
                    if (!tail) v8[e] = vbase[(size_t)key * vstride + 16 * blk + j];
                    else v8[e] = (key < 4) ? vbase[(size_t)key * vstride + 16 * blk + j] : 0.f; }
                o[blk] = o[blk] * alpha; o[blk] = __builtin_amdgcn_mfma_f32_16x16x32_bf16(pack8(v8), pf, o[blk], 0, 0, 0); }
        }
        lsum = xsum32(xsum16(lsum));
        LAS float* my = cmb + w * CW;
        if (grp == 0) { my[j] = mrow; my[16 + j] = lsum; }
#pragma unroll
        for (int blk = 0; blk < 8; ++blk)
#pragma unroll
            for (int r = 0; r < 4; ++r) my[32 + (16 * blk + 4 * grp + r) * 16 + j] = o[blk][r];
        __syncthreads();
        { const int t4 = tid >> 7, dv = tid & 127; float res[2];
#pragma unroll
            for (int q = 0; q < 2; ++q) { const int row = 4 * q + t4; float mx = -1e30f;
#pragma unroll
                for (int ww = 0; ww < 8; ++ww) mx = fmaxf(mx, cmb[ww * CW + row]);
                float L = 0.f, Ov = 0.f;
#pragma unroll
                for (int ww = 0; ww < 8; ++ww) { const float sc = __builtin_amdgcn_exp2f(cmb[ww * CW + row] - mx); L += cmb[ww * CW + 16 + row] * sc; Ov += cmb[ww * CW + 32 + dv * 16 + row] * sc; }
                res[q] = Ov / L; }
            const float val = res[0] - lam * res[1];
            const float ss = wave_sum(val * val);
            if (lane == 0) red[w] = ss;
            __syncthreads();
            const float tot = red[2 * t4] + red[2 * t4 + 1];
            const float ov = val * (1.0f / sqrtf(tot * (1.f / 128.f) + SUBLN_EPS)) * F.subln[dv] * (1.f - LAM_INIT);
            ((bf16*)(F.ws + WS_XM))[(size_t)(MP + DECS * b + t4) * DM + 512 + 128 * h + dv] = (bf16)f2bf(ov);
        }
        __syncthreads();
    }
}
__device__ __forceinline__ void prompt_attn(Frame& F, char* ldsg) {
    attn_body::lds_cfptr lut = (attn_body::lds_cfptr)(F.lds + LUTR_OFF);
    for (int i = F.vcu; i < NB * 16 * 8; i += F.G) {
        const int jj = i & 255, k = i >> 8, bvh = jj >> 1, s = 2 * (jj & 1) + (k >> 1), qb = (k & 1) ? 7 - s : s;
        const int b = bvh >> 4, vh = bvh & 15, h = vh >> 2, mp = (vh >> 1) & 1, half = vh & 1;
        const attn_body::bf16* Q = (const attn_body::bf16*)((bf16*)(F.ws + WS_QKV)) + (h * 2 + mp) * 64; const attn_body::bf16* K = (const attn_body::bf16*)((bf16*)(F.ws + WS_QKV)) + 512 + (h * 2 + mp) * 64;
        const attn_body::bf16* V = (const attn_body::bf16*)((bf16*)(F.ws + WS_QKV)) + 1024 + h * 128 + half * 64; attn_body::bf16* O = (attn_body::bf16*)((bf16*)(F.ws + WS_O)) + vh * 64;
        attn_body::attn_unit<8>(b, qb, Q, K, V, O, lut + h * 640, ldsg + RING_OFF);
    }
}
__device__ __forceinline__ void post_phase(Frame& F, float lam) {
    const int gw = F.vcu * NWAVES + F.wave, NGW = F.G * NWAVES, lane = F.lane, c0 = 8 * lane, hh = lane >> 3;
    f32x4 gnw[2], gnb[2];
    gnw[0] = *(const GAS f32x4*)(F.gn_w + c0); gnw[1] = *(const GAS f32x4*)(F.gn_w + c0 + 4); gnb[0] = *(const GAS f32x4*)(F.gn_b + c0); gnb[1] = *(const GAS f32x4*)(F.gn_b + c0 + 4);
    const int ah = lane >> 4, ahalf = (lane >> 3) & 1, ad = 8 * (lane & 7);
    f32x4 sl[2]; sl[0] = *(const GAS f32x4*)(F.subln + (c0 & 127)); sl[1] = *(const GAS f32x4*)(F.subln + (c0 & 127) + 4);
    for (int m = gw; m < M; m += NGW) {
        size_t sioff;
        if (m < MP) sioff = ((size_t)((m >> 11) * RH + hh) * SEQ + (m & (SEQ - 1))) * 384; else { const int ms = m - MP; sioff = SI_S0 + ((size_t)((ms >> 2) * RH + hh) * DECS + (ms & 3)) * 384; }
        const float* yp = ((float*)(F.ws + WS_Y)) + (size_t)m * 512 + c0; const float* vp = ((float*)(F.ws + WS_SI)) + sioff + 5 * 64 + (c0 & 63); const float* gp = ((float*)(F.ws + WS_G)) + (size_t)m * 512 + c0;
        f32x4 y[2], vr[2], g[2]; y[0] = *(const GAS f32x4*)yp; y[1] = *(const GAS f32x4*)(yp + 4); vr[0] = *(const GAS f32x4*)vp; vr[1] = *(const GAS f32x4*)(vp + 4); g[0] = *(const GAS f32x4*)gp; g[1] = *(const GAS f32x4*)(gp + 4);
        const float bon = ((float*)(F.ws + WS_BONUS))[(size_t)m * RH + hh];
        const float mean = red8((y[0][0] + y[0][1]) + (y[0][2] + y[0][3]) + (y[1][0] + y[1][1]) + (y[1][2] + y[1][3])) * (1.f / 64.f);
        const f32x4 d0 = y[0] - mean, d1 = y[1] - mean;
        const float var = red8((d0[0] * d0[0] + d0[1] * d0[1]) + (d0[2] * d0[2] + d0[3] * d0[3]) + (d1[0] * d1[0] + d1[1] * d1[1]) + (d1[2] * d1[2] + d1[3] * d1[3])) * (1.f / 64.f);
        const float rstd = 1.0f / sqrtf(var + GN_EPS);
        const f32x4 o0 = (d0 * rstd * gnw[0] + gnb[0] + vr[0] * bon) * g[0], o1 = (d1 * rstd * gnw[1] + gnb[1] + vr[1] * bon) * g[1];
        v4u w; w.x = pk2(o0[0], o0[1]); w.y = pk2(o0[2], o0[3]); w.z = pk2(o1[0], o1[1]); w.w = pk2(o1[2], o1[3]);
        *(GAS v4u*)(((bf16*)(F.ws + WS_XM)) + (size_t)m * DM + c0) = w;
        if (m < MP) {
            const v4u a = *(const GAS v4u*)(((bf16*)(F.ws + WS_O)) + (size_t)m * 1024 + 64 * (4 * ah + ahalf) + ad), bq = *(const GAS v4u*)(((bf16*)(F.ws + WS_O)) + (size_t)m * 1024 + 64 * (4 * ah + 2 + ahalf) + ad);
            float d[8]; const unsigned aa[4] = {a.x, a.y, a.z, a.w}, bb[4] = {bq.x, bq.y, bq.z, bq.w}; float ss = 0.f;
#pragma unroll
            for (int i = 0; i < 4; ++i) { const float a_lo = __uint_as_float(aa[i] << 16), a_hi = __uint_as_float(aa[i] & 0xffff0000u), b_lo = __uint_as_float(bb[i] << 16), b_hi = __uint_as_float(bb[i] & 0xffff0000u);
                d[2 * i] = a_lo - lam * b_lo; d[2 * i + 1] = a_hi - lam * b_hi; ss += d[2 * i] * d[2 * i] + d[2 * i + 1] * d[2 * i + 1]; }
            const float rs = (1.f - LAM_INIT) / sqrtf(red16(ss) * (1.f / 128.f) + SUBLN_EPS);
            v4u q; q.x = pk2(d[0] * rs * sl[0][0], d[1] * rs * sl[0][1]); q.y = pk2(d[2] * rs * sl[0][2], d[3] * rs * sl[0][3]); q.z = pk2(d[4] * rs * sl[1][0], d[5] * rs * sl[1][1]); q.w = pk2(d[6] * rs * sl[1][2], d[7] * rs * sl[1][3]);
            *(GAS v4u*)(((bf16*)(F.ws + WS_XM)) + (size_t)m * DM + 512 + c0) = q;
        }
    }
}
struct Args { const void* in[31]; float* out; unsigned char* ws; int ph_lo, ph_hi; };
__global__ void __launch_bounds__(NWAVES * 64, 2) mk_fwd(Args args) {
    extern __shared__ __attribute__((aligned(16))) unsigned char lds[];
    Frame F;
    F.lds = (LAS unsigned char*)lds; F.MISC = (volatile LAS unsigned*)(F.lds + MISC_OFF);
    F.tid = threadIdx.x; F.lane = F.tid & 63; F.wave = __builtin_amdgcn_readfirstlane(F.tid >> 6);
    F.G = gridDim.x; { const int bx = blockIdx.x; F.vcu = (F.G % 8 == 0) ? (bx % 8) * (F.G / 8) + bx / 8 : bx; }
    unsigned char* ws = args.ws;
    F.ctl = (gu32*)(ws + WS_CTL);
    F.x_p = (const float*)args.in[0]; F.x_s = (const float*)args.in[1]; F.cache_k = (const float*)args.in[2]; F.cache_v = (const float*)args.in[3]; F.page_table = (const int*)args.in[4];
    F.state_wkv = (const float*)args.in[5]; F.state_shift = (const float*)args.in[6]; F.gains = (const float*)args.in[7]; F.ff1_in = (const float*)args.in[8]; F.ff1_out = (const float*)args.in[9];
    F.ff2_in = (const float*)args.in[10]; F.ff2_out = (const float*)args.in[11]; F.w_in = (const float*)args.in[12]; F.w_out = (const float*)args.in[13]; F.rel_tab = (const float*)args.in[14];
    F.lq1 = (const float*)args.in[15]; F.lk1 = (const float*)args.in[16]; F.lq2 = (const float*)args.in[17]; F.lk2 = (const float*)args.in[18]; F.subln = (const float*)args.in[19];
    F.mu = (const float*)args.in[20]; F.w0 = (const float*)args.in[21]; F.w2 = (const float*)args.in[22]; F.a0 = (const float*)args.in[23]; F.a2 = (const float*)args.in[24]; F.g2 = (const float*)args.in[25];
    F.kkp = (const float*)args.in[26]; F.ka = (const float*)args.in[27]; F.rk = (const float*)args.in[28]; F.gn_w = (const float*)args.in[29]; F.gn_b = (const float*)args.in[30];
    F.out = args.out;
    F.ws = ws;
    for (int u = F.tid; u < (MISC_OFF + 128 - LDSCTL_OFF) / 4; u += NWAVES * 64) ((LAS unsigned*)(F.lds + LDSCTL_OFF))[u] = 0u;
    __syncthreads();
    XcdBarrier bar; bar.bar = (unsigned*)(F.ctl + CW_BAR); bar.x = 0; bar.st = nullptr;
    if (!MK_PER_PHASE) bar = xcd_barrier_post((unsigned*)(F.ctl + CW_BAR), F.MISC + 8);
#define GRID_BAR() do { if (!MK_PER_PHASE) xcd_barrier(bar); } while (0)
    const int lo = args.ph_lo, hi = args.ph_hi;
#ifndef MK_PHASE_MASK
#define MK_PHASE_MASK 0x1fff
#endif
#define IN(k) (((MK_PHASE_MASK >> (k)) & 1) && lo <= (k) && (k) < hi)
#define BOTH(k) (IN(k) && IN((k) + 1))
    const float* g = F.gains;
    if (IN(0)) { p0_prologue(F); if (BOTH(0)) GRID_BAR(); }
    if (IN(1)) { pg8::Gemm gm{((bf16*)(F.ws + WS_XN)), ((bf16*)(F.ws + WS_FF1IN)), M, 2 * DFF, DM}; pg8::StaticOrder S; S.init(M, 2 * DFF, F.G, (int)blockIdx.x); pg8::EpiSwiGLU E{((bf16*)(F.ws + WS_H)), DFF};
        pg8::gemm_phase<pg8::EpiSwiGLU, pg8::StaticOrder, true, true>(F.lds + RING_OFF, gm, S, E); if (BOTH(1)) GRID_BAR(); }
    if (IN(2)) { pg8::Gemm gm{((bf16*)(F.ws + WS_H)), ((bf16*)(F.ws + WS_FF1OUT)), M, DM, DFF}; pg8::StaticOrder S; S.init(M, DM, F.G, (int)blockIdx.x); pg8::EpiF32 E{((float*)(F.ws + WS_F)), DM};
        pg8::gemm_phase<pg8::EpiF32, pg8::StaticOrder, true, true>(F.lds + RING_OFF, gm, S, E); if (BOTH(2)) GRID_BAR(); }
    if (IN(3)) { rowwise_phase<true>(F, F.x_p, F.x_s, ((float*)(F.ws + WS_HRES)), g + 1 * DM, 0.5f, g + 2 * DM); if (BOTH(3)) GRID_BAR(); }
    if (IN(4)) { pg8::Gemm gm{((bf16*)(F.ws + WS_XN)), ((bf16*)(F.ws + WS_WIN)), M, PCOLS, DM}; pg8::StaticOrder S; S.init(M, PCOLS, F.G, (int)blockIdx.x);
        pg8::EpiWin E{((bf16*)(F.ws + WS_QKV)), ((float*)(F.ws + WS_PR)), F.out + OUT_KP, F.out + OUT_VP, F.out + OUT_KS, F.out + OUT_VS, F.out + OUT_SP, F.out + OUT_SS, QSCALE, MP, SEQ};
        pg8::gemm_phase<pg8::EpiWin, pg8::StaticOrder, true, true>(F.lds + RING_OFF, gm, S, E); if (BOTH(4)) GRID_BAR(); }
    if (IN(5)) { prep_phase(F); if (BOTH(5)) GRID_BAR(); }
    if (IN(6)) {
        LAS float* lutR = (LAS float*)(F.lds + LUTR_OFF); LAS float* lutD = (LAS float*)(F.lds + LUTD_OFF);
        for (int i = F.tid; i < 4 * 640; i += NWAVES * 64) { const int h = i / 640, j = i % 640, n = 383 - j; lutR[i] = n < 0 ? -INFINITY : bias_delta(F.rel_tab, n, h); }
        for (int i = F.tid; i < 4 * 128; i += NWAVES * 64) lutD[i] = bias_delta(F.rel_tab, i & 127, i >> 7);
        __syncthreads();
#ifndef MK_P6_MASK
#define MK_P6_MASK 15
#endif
        if (MK_P6_MASK & 1) scan_sample(F);
        if (MK_P6_MASK & 2) scan_prompt(F);
        if (MK_P6_MASK & 4) prompt_attn(F, (char*)lds);
        if (MK_P6_MASK & 8) { const float lam = compute_lam(F); decode_attn(F, lam); }
        if (BOTH(6)) GRID_BAR(); }
    if (IN(7)) { const float lam = compute_lam(F); post_phase(F, lam); if (BOTH(7)) GRID_BAR(); }
    if (IN(8)) { pg8::Gemm gm{((bf16*)(F.ws + WS_XM)), ((bf16*)(F.ws + WS_WOUT)), M, DM, DM}; pg8::StaticOrder S; S.init(M, DM, F.G, (int)blockIdx.x); pg8::EpiF32 E{((float*)(F.ws + WS_F)), DM};
        pg8::gemm_phase<pg8::EpiF32, pg8::StaticOrder, true, true>(F.lds + RING_OFF, gm, S, E); if (BOTH(8)) GRID_BAR(); }
    if (IN(9)) { rowwise_phase<true>(F, ((float*)(F.ws + WS_HRES)), ((float*)(F.ws + WS_HRES)) + (size_t)MP * DM, ((float*)(F.ws + WS_HRES)), g + 3 * DM, 1.0f, g + 4 * DM); if (BOTH(9)) GRID_BAR(); }
    if (IN(10)) { pg8::Gemm gm{((bf16*)(F.ws + WS_XN)), ((bf16*)(F.ws + WS_FF2IN)), M, 2 * DFF, DM}; pg8::StaticOrder S; S.init(M, 2 * DFF, F.G, (int)blockIdx.x); pg8::EpiSwiGLU E{((bf16*)(F.ws + WS_H)), DFF};
        pg8::gemm_phase<pg8::EpiSwiGLU, pg8::StaticOrder, true, true>(F.lds + RING_OFF, gm, S, E); if (BOTH(10)) GRID_BAR(); }
    if (IN(11)) { pg8::Gemm gm{((bf16*)(F.ws + WS_H)), ((bf16*)(F.ws + WS_FF2OUT)), M, DM, DFF}; pg8::StaticOrder S; S.init(M, DM, F.G, (int)blockIdx.x); pg8::EpiF32 E{((float*)(F.ws + WS_F)), DM};
        pg8::gemm_phase<pg8::EpiF32, pg8::StaticOrder, true, true>(F.lds + RING_OFF, gm, S, E); if (BOTH(11)) GRID_BAR(); }
    if (IN(12)) { rowwise_phase<false>(F, ((float*)(F.ws + WS_HRES)), ((float*)(F.ws + WS_HRES)) + (size_t)MP * DM, F.out + OUT_Y, g + 5 * DM, 0.5f, g + 5 * DM); }
#undef IN
#undef BOTH
#undef GRID_BAR
}

extern "C" void kernel_launch(void* const* d_in, const int* in_sizes, int n_in, void* d_out, int out_size, void* d_ws, size_t ws_size, hipStream_t stream) {
    static int grid = 0;
    if (grid == 0) {
        if (n_in != 31 || (size_t)out_size != OUT_END || ws_size < WS_END) { fprintf(stderr, "kernel_launch: unexpected shapes: n_in %d out %d ws %zu\n", n_in, out_size, ws_size); grid = -1; return; }
        int dev = 0, cus = 0, per_cu = 0;
        if (hipGetDevice(&dev) != hipSuccess || hipDeviceGetAttribute(&cus, hipDeviceAttributeMultiprocessorCount, dev) != hipSuccess) { grid = -1; return; }
        if (hipFuncSetAttribute((const void*)mk_fwd, hipFuncAttributeMaxDynamicSharedMemorySize, LDS_BYTES) != hipSuccess) { fprintf(stderr, "kernel_launch: hipFuncSetAttribute failed\n"); grid = -1; return; }
        if (hipOccupancyMaxActiveBlocksPerMultiprocessor(&per_cu, (const void*)mk_fwd, NWAVES * 64, LDS_BYTES) != hipSuccess || per_cu < 1) fprintf(stderr, "kernel_launch: occupancy query reports %d\n", per_cu);
        (void)hipGetLastError();
        grid = cus;
    }
    if (grid < 0) return;
    if (hipMemsetAsync((char*)d_ws + WS_CTL, 0, CTL_ZERO_BYTES, stream) != hipSuccess) return;
    Args a{};
    for (int i = 0; i < 31; ++i) a.in[i] = d_in[i];
    a.out = (float*)d_out; a.ws = (unsigned char*)d_ws;
#if MK_PER_PHASE
    for (int p = 0; p < NPHASE; ++p) { a.ph_lo = p; a.ph_hi = p + 1; hipLaunchKernelGGL(mk_fwd, dim3(grid), dim3(NWAVES * 64), LDS_BYTES, stream, a); }
#else
    a.ph_lo = 0; a.ph_hi = NPHASE; hipLaunchKernelGGL(mk_fwd, dim3(grid), dim3(NWAVES * 64), LDS_BYTES, stream, a);
#endif
}
```

```cpp
#include <hip/hip_runtime.h>
#include <cstdio>
#include <cstdint>
#ifndef MK_PER_PHASE
#define MK_PER_PHASE 0
#endif

namespace pg8 {
#define PG8_LAS __attribute__((address_space(3)))
typedef unsigned short bf16_t;
typedef short bf16x8 __attribute__((ext_vector_type(8)));
typedef float f32x4 __attribute__((ext_vector_type(4)));
typedef unsigned u32x4 __attribute__((ext_vector_type(4)));
constexpr int BM = 256, BK = 64, HALF = 128, HTB = HALF * BK * 2  , STAGE_BYTES = 8 * HTB, NXCD = 8, WGM = 8;

__host__ __device__ __forceinline__ int lds_byte(int r, int c) { const int st = (r >> 4) * 2 + (c >> 5), rr = r & 15, cc = c & 31, ob = rr * 64 + cc * 2; return st * 1024 + (ob ^ (((ob >> 9) & 1) << 5)); }
__host__ __device__ __forceinline__ void stage_rc(int b, int& R, int& C) { const int st = b / 1024, sb = b % 1024, swz = sb ^ (((sb >> 9) & 1) << 5); R = (st >> 1) * 16 + swz / 64; C = (st & 1) * 32 + (swz % 64) / 2; }
__host__ __device__ __forceinline__ int perm32(int rho) { const int n = rho >> 4, i = rho & 15; return 8 * (i >> 2) + 4 * n + (i & 3); }

struct Unit { int pm, pn, kt0, nkt; };
struct Gemm { const bf16_t* A; const bf16_t* Bt; int M, N, K; };

struct StaticOrder {
    int nM, nN, nwg, G, c, nkt;
    __host__ __device__ void init(int M, int N, int G_, int c_, int K_) { nM = M / BM; nN = N / BM; nwg = nM * nN; G = G_; c = c_; nkt = K_ / BK; }
    __host__ __device__ bool next(int i, Unit& u) const {
        const long L = (long)i * G + c; if (L >= nwg) return false;
        int wgid = (int)L; { const int q = nwg / NXCD, r = nwg % NXCD, xcd = wgid % NXCD, off = wgid / NXCD; wgid = (xcd < r ? xcd * (q + 1) : r * (q + 1) + (xcd - r) * q) + off; }
        const int nig = WGM * nN, gid = wgid / nig, fm = gid * WGM, gsz = (nM - fm) < WGM ? (nM - fm) : WGM;
        u.pm = fm + ((wgid % nig) % gsz); u.pn = (wgid % nig) / gsz; u.kt0 = 0; u.nkt = nkt; return true;
    }
    __device__ __forceinline__ void a_ready(const Unit&) const {}
    __device__ __forceinline__ void done(const Unit&) const {}
};

constexpr int SPLIT_KT = 4;
struct TailSplitOrder {
    StaticOrder main; int nmain, nsplit, ntail, G, c, pm0, nN;
    __host__ __device__ void init(int Mmain, int Mtail, int N, int G_, int c_, int K_) { main.init(Mmain, N, G_, c_, K_); nmain = main.nwg; nN = N / BM; nsplit = (K_ / BK) / SPLIT_KT; ntail = (Mtail / BM) * nN * nsplit; G = G_; c = c_; pm0 = Mmain / BM; }
    __host__ __device__ bool next(int i, Unit& u) const {
        const long L = (long)i * G + c; if (L < nmain) return main.next(i, u);
        const int t = (int)(L - nmain); if (t >= ntail) return false;
        const int ks = t % nsplit, r = t / nsplit; u.pn = r % nN; u.pm = pm0 + r / nN; u.kt0 = ks * SPLIT_KT; u.nkt = SPLIT_KT; return true;
    }
    __device__ __forceinline__ void a_ready(const Unit&) const {}
    __device__ __forceinline__ void done(const Unit&) const {}
};

__device__ __forceinline__ unsigned cvt_pk_bf16(float lo, float hi) { unsigned r; asm volatile("v_cvt_pk_bf16_f32 %0, %1, %2" : "=v"(r) : "v"(lo), "v"(hi)); return r; }
typedef float f32x2 __attribute__((ext_vector_type(2)));
__device__ __forceinline__ f32x2 gelu_pk(f32x2 v) {
    const f32x2 av = __builtin_elementwise_abs(v), d = av * 0.2316418882f + 1.0f;
    f32x2 t; t.x = __builtin_amdgcn_rcpf(d.x); t.y = __builtin_amdgcn_rcpf(d.y);
    f32x2 q = t * 0.5307027145f + (-0.7265760135f); q = q * t + 0.7107068705f; q = q * t + (-0.142248368f); q = q * t + 0.127414796f; q = q * t;
    const f32x2 s = (v * v) * (-0.72134752044f);
    f32x2 e; e.x = __builtin_amdgcn_exp2f(s.x); e.y = __builtin_amdgcn_exp2f(s.y);
    const f32x2 m = v * (q * e), r = v - m;
    f32x2 o; o.x = v.x < 0.f ? m.x : r.x; o.y = v.y < 0.f ? m.y : r.y; return o;
}

template <int ACT  > struct EpiBf16 {
    static constexpr bool PERM = true, AFTER_DRAIN = false; static_assert(ACT == 0 || ACT == 1, "EpiBf16: ACT is 0 (none) or 1 (gelu_pk)");
    bf16_t* O; int ldc; const float* bias; int split_cols; size_t split_stride; float scale0;
    __device__ __forceinline__ void operator()(const f32x4 (&acc)[2][2][4][2], const Unit& u, int wr, int wc, int fr, int fq) const {
        const int row0 = u.pm * BM + wr * 64 + fr; int colt = u.pn * BM; bf16_t* base = O;
        float sc = 1.f; if (split_cols) { const int t = colt / split_cols; base += (size_t)t * split_stride; colt -= t * split_cols; if (t == 0) sc = scale0; }
        const int col0 = colt + wc * 32 + 8 * fq, bcol0 = u.pn * BM + wc * 32 + 8 * fq;
        f32x4 bv[2][2];
#pragma unroll
        for (int bj = 0; bj < 2; ++bj)
#pragma unroll
            for (int n = 0; n < 2; ++n) bv[bj][n] = bias ? *(const f32x4*)(bias + bcol0 + bj * HALF + 4 * n) : (f32x4){0.f, 0.f, 0.f, 0.f};
#pragma unroll
        for (int ai = 0; ai < 2; ++ai)
#pragma unroll
            for (int m = 0; m < 4; ++m) { bf16_t* rowp = base + (size_t)(row0 + ai * HALF + m * 16) * ldc + col0;
#pragma unroll
                for (int bj = 0; bj < 2; ++bj) { f32x4 v0 = acc[ai][bj][m][0] + bv[bj][0], v1 = acc[ai][bj][m][1] + bv[bj][1];
                    if (ACT == 1) { f32x2 a = gelu_pk((f32x2){v0[0], v0[1]}), b = gelu_pk((f32x2){v0[2], v0[3]}), c = gelu_pk((f32x2){v1[0], v1[1]}), d = gelu_pk((f32x2){v1[2], v1[3]});
                        v0 = (f32x4){a.x, a.y, b.x, b.y}; v1 = (f32x4){c.x, c.y, d.x, d.y}; }
                    v0 = v0 * sc; v1 = v1 * sc; u32x4 w; w.x = cvt_pk_bf16(v0[0], v0[1]); w.y = cvt_pk_bf16(v0[2], v0[3]); w.z = cvt_pk_bf16(v1[0], v1[1]); w.w = cvt_pk_bf16(v1[2], v1[3]);
                    *(u32x4*)(rowp + bj * HALF) = w; } }
    }
};

struct PanelStats {
    unsigned* xbuf;
    unsigned* cnt;
    unsigned* tmo;
    int ntn; float eps;
    unsigned code;
    __device__ __forceinline__ bool run(const f32x4 (&v)[2][2][4][2], const Unit& u, int wr, int wc, int fr, int fq, PG8_LAS unsigned char* lds, int wid, int lane) const {
        typedef float f32x2v __attribute__((ext_vector_type(2)));
        PG8_LAS f32x2v* P = (PG8_LAS f32x2v*)lds;
        PG8_LAS f32x2v* S = (PG8_LAS f32x2v*)(lds + 8192);
        PG8_LAS unsigned* flag = (PG8_LAS unsigned*)(lds + 8192 + 2048);
#pragma unroll
        for (int ai = 0; ai < 2; ++ai)
#pragma unroll
            for (int m = 0; m < 4; ++m) {
                float s = 0.f;
#pragma unroll
                for (int bj = 0; bj < 2; ++bj)
#pragma unroll
                    for (int n = 0; n < 2; ++n) { const f32x4 x = v[ai][bj][m][n]; s += (x[0] + x[1]) + (x[2] + x[3]); }
                s += __shfl_xor(s, 16); s += __shfl_xor(s, 32);
                const float mw = s * (1.0f / 64.0f); float q = 0.f;
#pragma unroll
                for (int bj = 0; bj < 2; ++bj)
#pragma unroll
                    for (int n = 0; n < 2; ++n) { const f32x4 d = v[ai][bj][m][n] - mw; q += (d[0] * d[0] + d[1] * d[1]) + (d[2] * d[2] + d[3] * d[3]); }
                q += __shfl_xor(q, 16); q += __shfl_xor(q, 32);
                if (fq == 0) P[(ai * HALF + wr * 64 + m * 16 + fr) * 4 + wc] = (f32x2v){mw, q};
            }
        asm volatile("s_waitcnt lgkmcnt(0)" ::: "memory"); __builtin_amdgcn_s_barrier(); asm volatile("" ::: "memory");
#if defined(BROKEN_EXCHANGE_NO_WAIT)
#warning BROKEN CONTROL BUILD: the row-statistics exchange does not wait; results are wrong by design
        if (blockIdx.x >= 64) { const long long t0_ = clock64(); while (clock64() - t0_ < 60000) __builtin_amdgcn_s_sleep(8); }
#endif
        const int row = wid * 32 + (lane & 31);
        if (lane < 32) {
            const f32x2v a = P[row * 4 + 0], b = P[row * 4 + 1], c = P[row * 4 + 2], d = P[row * 4 + 3];
            const float mt = (a.x + b.x + c.x + d.x) * 0.25f;
            const float da = a.x - mt, db = b.x - mt, dc = c.x - mt, dd = d.x - mt;
            const float m2 = (a.y + b.y) + (c.y + d.y) + 64.0f * ((da * da + db * db) + (dc * dc + dd * dd));
            unsigned long long* slot = (unsigned long long*)xbuf + ((size_t)(u.pm * BM + row) * 4 + u.pn);
            __hip_atomic_store(slot, ((unsigned long long)__float_as_uint(m2) << 32) | __float_as_uint(mt), __ATOMIC_RELAXED, __HIP_MEMORY_SCOPE_AGENT);
        }
        asm volatile("s_waitcnt vmcnt(0)" ::: "memory");
        if (lane == 0) __hip_atomic_fetch_add(cnt + 64 * u.pm, 1u, __ATOMIC_RELAXED, __HIP_MEMORY_SCOPE_AGENT);
        if (wid == 0) {
            bool dead = false; const unsigned long long t0 = __builtin_amdgcn_s_memrealtime(); const unsigned want = 8u * (unsigned)ntn;
            for (;;) {
#if defined(BROKEN_EXCHANGE_NO_WAIT)
                break;
#endif
                if ((unsigned)__builtin_amdgcn_readfirstlane(__hip_atomic_load(cnt + 64 * u.pm, __ATOMIC_RELAXED, __HIP_MEMORY_SCOPE_AGENT)) >= want) break;
                if (__builtin_amdgcn_s_memrealtime() - t0 > 2000000ull) {
                    if (lane == 0) { unsigned expect = 0u; __hip_atomic_compare_exchange_strong(tmo + 1, &expect, code | (unsigned)(u.pm & 0xff), __ATOMIC_RELAXED, __ATOMIC_RELAXED, __HIP_MEMORY_SCOPE_AGENT);
                                     __hip_atomic_store(tmo, 1u, __ATOMIC_RELAXED, __HIP_MEMORY_SCOPE_AGENT); }
                    dead = true; break; }
                __builtin_amdgcn_s_sleep(2);
            }
            __builtin_amdgcn_fence(__ATOMIC_ACQUIRE, "agent");
            if (lane == 0) flag[0] = dead ? 1u : 0u;
        }
        asm volatile("s_waitcnt vmcnt(0) lgkmcnt(0)" ::: "memory"); __builtin_amdgcn_s_barrier(); asm volatile("" ::: "memory");
        const bool bad = flag[0] != 0u;
        if (lane < 32) {
            const unsigned long long* slot = (const unsigned long long*)xbuf + (size_t)(u.pm * BM + row) * 4; float mt[4], m2[4]; float ms = 0.f;
#pragma unroll
            for (int t = 0; t < 4; ++t) { if (t < ntn) { const unsigned long long w = __hip_atomic_load(slot + t, __ATOMIC_RELAXED, __HIP_MEMORY_SCOPE_AGENT); mt[t] = __uint_as_float((unsigned)w); m2[t] = __uint_as_float((unsigned)(w >> 32)); } else { mt[t] = 0.f; m2[t] = 0.f; } ms += mt[t]; }
            const float mean = ms / (float)ntn; float q = 0.f;
#pragma unroll
            for (int t = 0; t < 4; ++t) if (t < ntn) { const float dm = mt[t] - mean; q += m2[t] + 256.0f * dm * dm; }
            S[row] = (f32x2v){mean, 1.0f / sqrtf(q / (256.0f * (float)ntn) + eps)};
        }
        asm volatile("s_waitcnt lgkmcnt(0)" ::: "memory"); __builtin_amdgcn_s_barrier(); asm volatile("" ::: "memory");
        return bad;
    }
};
struct EpiLnRes {
    static constexpr bool PERM = false, AFTER_DRAIN = true;
    const float* base; float* out; int ldc; const float* bias; PanelStats st; unsigned poison;
    __device__ __forceinline__ void fused(f32x4 (&acc)[2][2][4][2], const Unit& u, int wr, int wc, int fr, int fq, PG8_LAS unsigned char* lds, int wid, int lane) const {
        typedef float f32x2v __attribute__((ext_vector_type(2)));
        const PG8_LAS f32x2v* S = (const PG8_LAS f32x2v*)(lds + 8192);
        const int col0 = u.pn * BM + wc * 32 + 4 * fq;
#pragma unroll
        for (int bj = 0; bj < 2; ++bj)
#pragma unroll
            for (int n = 0; n < 2; ++n) { const f32x4 bv = bias ? *(const f32x4*)(bias + col0 + bj * HALF + n * 16) : (f32x4){0.f, 0.f, 0.f, 0.f};
#pragma unroll
                for (int ai = 0; ai < 2; ++ai)
#pragma unroll
                    for (int m = 0; m < 4; ++m) acc[ai][bj][m][n] += bv; }
        f32x4 pre[4][2][2];
#pragma unroll
        for (int m = 0; m < 4; ++m) { const size_t off = (size_t)(u.pm * BM + wr * 64 + m * 16 + fr) * ldc + col0;
#pragma unroll
            for (int bj = 0; bj < 2; ++bj)
#pragma unroll
                for (int n = 0; n < 2; ++n) pre[m][bj][n] = *(const f32x4*)(base + off + bj * HALF + n * 16); }
        const bool bad = st.run(acc, u, wr, wc, fr, fq, lds, wid, lane) || poison != 0u;
        const float qnan = __builtin_nanf("");
#pragma unroll
        for (int ai = 0; ai < 2; ++ai)
#pragma unroll
            for (int m = 0; m < 4; ++m) { const int r = ai * HALF + wr * 64 + m * 16 + fr; const f32x2v sr = S[r]; const size_t off = (size_t)(u.pm * BM + r) * ldc + col0;
#pragma unroll
                for (int bj = 0; bj < 2; ++bj)
#pragma unroll
                    for (int n = 0; n < 2; ++n) { const f32x4 bs = ai == 0 ? pre[m][bj][n] : *(const f32x4*)(base + off + bj * HALF + n * 16); f32x4 o = bs + (acc[ai][bj][m][n] - sr.x) * sr.y;
                        if (bad) o = (f32x4){qnan, qnan, qnan, qnan}; *(f32x4*)(out + off + bj * HALF + n * 16) = o; }
                if (m & 1) asm volatile("" ::: "memory"); }
    }
};
struct EpiLnResLn {
    static constexpr bool PERM = false, AFTER_DRAIN = true;
    const float* base; float* out; bf16_t* xn; int ldc; const float* bias; PanelStats st1, st2; unsigned poison;
    __device__ __forceinline__ void fused(f32x4 (&acc)[2][2][4][2], const Unit& u, int wr, int wc, int fr, int fq, PG8_LAS unsigned char* lds, int wid, int lane) const {
        typedef float f32x2v __attribute__((ext_vector_type(2))); typedef unsigned u32x2v __attribute__((ext_vector_type(2)));
        const PG8_LAS f32x2v* S = (const PG8_LAS f32x2v*)(lds + 8192);
        const int col0 = u.pn * BM + wc * 32 + 4 * fq;
#pragma unroll
        for (int bj = 0; bj < 2; ++bj)
#pragma unroll
            for (int n = 0; n < 2; ++n) { const f32x4 bv = bias ? *(const f32x4*)(bias + col0 + bj * HALF + n * 16) : (f32x4){0.f, 0.f, 0.f, 0.f};
#pragma unroll
                for (int ai = 0; ai < 2; ++ai)
#pragma unroll
                    for (int m = 0; m < 4; ++m) acc[ai][bj][m][n] += bv; }
        bool bad = st1.run(acc, u, wr, wc, fr, fq, lds, wid, lane) || poison != 0u;
        const float qnan = __builtin_nanf("");
#pragma unroll
        for (int ai = 0; ai < 2; ++ai)
#pragma unroll
            for (int m = 0; m < 4; ++m) { const int r = ai * HALF + wr * 64 + m * 16 + fr; const f32x2v sr = S[r]; const size_t off = (size_t)(u.pm * BM + r) * ldc + col0;
#pragma unroll
                for (int bj = 0; bj < 2; ++bj)
#pragma unroll
                    for (int n = 0; n < 2; ++n) { const f32x4 bs = *(const f32x4*)(base + off + bj * HALF + n * 16); acc[ai][bj][m][n] = bs + (acc[ai][bj][m][n] - sr.x) * sr.y; }
                asm volatile("" : "+v"(acc[ai][0][m][0]), "+v"(acc[ai][0][m][1]), "+v"(acc[ai][1][m][0]), "+v"(acc[ai][1][m][1]));
                if (m & 1) asm volatile("" ::: "memory"); }
        const bool bad1 = bad;
        bad = st2.run(acc, u, wr, wc, fr, fq, lds, wid, lane) || bad;
#pragma unroll
        for (int ai = 0; ai < 2; ++ai)
#pragma unroll
            for (int m = 0; m < 4; ++m) { const int r = ai * HALF + wr * 64 + m * 16 + fr; const f32x2v sr = S[r]; const size_t off = (size_t)(u.pm * BM + r) * ldc + col0;
#pragma unroll
                for (int bj = 0; bj < 2; ++bj)
#pragma unroll
                    for (int n = 0; n < 2; ++n) { const f32x4 x1 = acc[ai][bj][m][n]; *(f32x4*)(out + off + bj * HALF + n * 16) = bad1 ? (f32x4){qnan, qnan, qnan, qnan} : x1;
                        const f32x4 o = (x1 - sr.x) * sr.y; u32x2v w; w.x = cvt_pk_bf16(o[0], o[1]); w.y = cvt_pk_bf16(o[2], o[3]);
                        if (bad) { w.x = 0x7fc07fc0u; w.y = 0x7fc07fc0u; } *(u32x2v*)(xn + off + bj * HALF + n * 16) = w; }
                asm volatile("" ::: "memory"); }
    }
};

template <class Epi, class Sched, bool ALIGN_EPI = false, bool SP2 = false>
__device__ __forceinline__ void gemm_phase(PG8_LAS unsigned char* lds, const Gemm g, const Sched& S, const Epi& E) {
    const int tid = threadIdx.x, wid = __builtin_amdgcn_readfirstlane(tid >> 6), lane = tid & 63, wr = wid >> 2, wc = wid & 3, fr = lane & 15, fq = lane >> 4;
    const int K = g.K;
    unsigned voffA[2], voffB[2];
#pragma unroll
    for (int i = 0; i < 2; ++i) { int R, C; stage_rc(tid * 16 + i * 8192, R, C); const int Rb = Epi::PERM ? ((R & ~31) + perm32(R & 31)) : R;
        voffA[i] = (unsigned)(R * K + C) * 2u; voffB[i] = (unsigned)(Rb * K + C) * 2u; }
    const size_t kstep = (size_t)(BK * 2);
    const size_t hstep = (size_t)HALF * K * 2;
    const size_t tstep = 2 * hstep;
    const unsigned ldsw = (unsigned)wid * 1024u;
    const int aoff = lds_byte(wr * 64 + fr, fq * 8), boff = lds_byte(wc * 32 + fr, fq * 8);
#define PG8_SA(b, h) (((b) * 2 + (h)) * HTB)
#define PG8_SB(b, h) ((4 + (b) * 2 + (h)) * HTB)
#define PG8_STAGE(bufoff, gbase, voff) do { _Pragma("unroll") for (int _i = 0; _i < 2; ++_i) \
        __builtin_amdgcn_global_load_lds((const unsigned*)((const char*)(gbase) + (voff)[_i]), (PG8_LAS unsigned*)(lds + (bufoff) + ldsw + _i * 8192), 16, 0, 0); } while (0)
#define PG8_LDA(dst, b, h) do { _Pragma("unroll") for (int m = 0; m < 4; ++m) _Pragma("unroll") for (int k = 0; k < 2; ++k) dst[m][k] = *(const PG8_LAS bf16x8*)(lds + PG8_SA(b, h) + aoff + m * 2048 + k * 1024); } while (0)
#define PG8_LDB(dst, b, h) do { _Pragma("unroll") for (int n = 0; n < 2; ++n) _Pragma("unroll") for (int k = 0; k < 2; ++k) dst[n][k] = *(const PG8_LAS bf16x8*)(lds + PG8_SB(b, h) + boff + n * 2048 + k * 1024); } while (0)
#define PG8_MMA(ai, bj, At, Bt) do { __builtin_amdgcn_s_setprio(1); _Pragma("unroll") for (int m = 0; m < 4; ++m) _Pragma("unroll") for (int n = 0; n < 2; ++n) _Pragma("unroll") for (int k = 0; k < 2; ++k) \
        acc[ai][bj][m][n] = __builtin_amdgcn_mfma_f32_16x16x32_bf16(Bt[n][k], At[m][k], acc[ai][bj][m][n], 0, 0, 0); __builtin_amdgcn_s_setprio(0); } while (0)
#define PG8_WAIT_V(n) asm volatile("s_waitcnt vmcnt(" #n ")" ::: "memory")
#define PG8_WAIT_L(n) asm volatile("s_waitcnt lgkmcnt(" #n ")" ::: "memory")
#define PG8_BAR __builtin_amdgcn_s_barrier()
#define PG8_SCHED __builtin_amdgcn_sched_barrier(0)
    Unit cur, nxt; int ui = 0;
    if (!S.next(0, cur)) return;
    f32x4 acc[2][2][4][2];
#pragma unroll
    for (int a = 0; a < 2; ++a)
#pragma unroll
        for (int b = 0; b < 2; ++b)
#pragma unroll
            for (int m = 0; m < 4; ++m)
#pragma unroll
                for (int n = 0; n < 2; ++n) acc[a][b][m][n] = (f32x4){0.f, 0.f, 0.f, 0.f};
    bf16x8 At[4][2], B0[2][2], B1[2][2];
    const char* cA = (const char*)g.A + (size_t)cur.pm * tstep + (size_t)cur.kt0 * kstep; const char* cB = (const char*)g.Bt + (size_t)cur.pn * tstep + (size_t)cur.kt0 * kstep;
    int nt = cur.nkt;
    S.a_ready(cur);
    if constexpr (SP2) {
        PG8_STAGE(PG8_SB(0, 0), cB, voffB); PG8_STAGE(PG8_SB(0, 1), cB + hstep, voffB); PG8_STAGE(PG8_SA(0, 0), cA, voffA); PG8_STAGE(PG8_SA(0, 1), cA + hstep, voffA);
        if (wr == 1) PG8_BAR;
        PG8_WAIT_V(2); PG8_BAR;
        PG8_STAGE(PG8_SB(1, 0), cB + kstep, voffB); PG8_STAGE(PG8_SA(1, 0), cA + kstep, voffA); PG8_STAGE(PG8_SB(1, 1), cB + hstep + kstep, voffB);
        PG8_WAIT_V(6); PG8_BAR;
    } else {
        PG8_STAGE(PG8_SB(0, 0), cB, voffB); PG8_STAGE(PG8_SA(0, 0), cA, voffA); PG8_STAGE(PG8_SB(0, 1), cB + hstep, voffB); PG8_STAGE(PG8_SA(0, 1), cA + hstep, voffA);
        if (wr == 1) PG8_BAR;
        PG8_WAIT_V(4); PG8_BAR;
        PG8_STAGE(PG8_SB(1, 0), cB + kstep, voffB); PG8_STAGE(PG8_SA(1, 0), cA + kstep, voffA); PG8_STAGE(PG8_SB(1, 1), cB + hstep + kstep, voffB);
        PG8_WAIT_V(6); PG8_BAR;
    }
    for (;;) {
        const bool has_next = S.next(ui + 1, nxt);
        const char* nA = has_next ? (const char*)g.A + (size_t)nxt.pm * tstep + (size_t)nxt.kt0 * kstep : cA; const char* nB = has_next ? (const char*)g.Bt + (size_t)nxt.pn * tstep + (size_t)nxt.kt0 * kstep : cB;
        for (int t = 0; t < nt; t += 2) {
            const bool last = (t == nt - 2);
            const char* a1 = cA + (size_t)(t + 1) * kstep;
            const char* a2 = last ? nA : cA + (size_t)(t + 2) * kstep; const char* b2 = last ? nB : cB + (size_t)(t + 2) * kstep;
            const char* a3 = a2 + kstep; const char* b3 = b2 + kstep;
            if (last && has_next) S.a_ready(nxt);
            if constexpr (SP2) {
            PG8_LDB(B0, 0, 0); PG8_LDB(B1, 0, 1); PG8_SCHED; PG8_LDA(At, 0, 0); PG8_STAGE(PG8_SA(1, 1), a1 + hstep, voffA);
            PG8_WAIT_V(8); PG8_WAIT_L(0); PG8_BAR; PG8_MMA(0, 0, At, B0); PG8_MMA(0, 1, At, B1); PG8_BAR; PG8_SCHED;
            PG8_LDA(At, 0, 1); PG8_STAGE(PG8_SB(0, 0), b2, voffB); PG8_STAGE(PG8_SB(0, 1), b2 + hstep, voffB); PG8_STAGE(PG8_SA(0, 0), a2, voffA);
            PG8_WAIT_V(8); PG8_WAIT_L(0); PG8_BAR; PG8_MMA(1, 0, At, B0); PG8_MMA(1, 1, At, B1); PG8_BAR; PG8_SCHED;
            PG8_LDB(B0, 1, 0); PG8_LDB(B1, 1, 1); PG8_SCHED; PG8_LDA(At, 1, 0); PG8_STAGE(PG8_SA(0, 1), a2 + hstep, voffA);
            PG8_WAIT_V(8); PG8_WAIT_L(0); PG8_BAR; PG8_MMA(0, 0, At, B0); PG8_MMA(0, 1, At, B1); PG8_BAR; PG8_SCHED;
            PG8_LDA(At, 1, 1); PG8_STAGE(PG8_SB(1, 0), b3, voffB); PG8_STAGE(PG8_SB(1, 1), b3 + hstep, voffB); PG8_STAGE(PG8_SA(1, 0), a3, voffA);
            PG8_WAIT_V(8); PG8_WAIT_L(0); PG8_BAR; PG8_MMA(1, 0, At, B0); PG8_MMA(1, 1, At, B1); PG8_BAR; PG8_SCHED;
            } else {
            PG8_LDB(B0, 0, 0); PG8_SCHED; PG8_LDA(At, 0, 0); PG8_STAGE(PG8_SA(1, 1), a1 + hstep, voffA);
            PG8_WAIT_L(8); PG8_BAR; PG8_WAIT_L(0); PG8_MMA(0, 0, At, B0); PG8_BAR; PG8_SCHED;
            PG8_LDB(B1, 0, 1); PG8_STAGE(PG8_SB(0, 0), b2, voffB);
            PG8_BAR; PG8_WAIT_L(0); PG8_MMA(0, 1, At, B1); PG8_BAR;
            PG8_LDA(At, 0, 1); PG8_STAGE(PG8_SA(0, 0), a2, voffA);
            PG8_BAR; PG8_WAIT_L(0); PG8_MMA(1, 0, At, B0); PG8_BAR; PG8_SCHED;
            PG8_STAGE(PG8_SB(0, 1), b2 + hstep, voffB);
            PG8_WAIT_V(6); PG8_BAR; PG8_MMA(1, 1, At, B1); PG8_BAR;
            PG8_LDB(B0, 1, 0); PG8_SCHED; PG8_LDA(At, 1, 0); PG8_STAGE(PG8_SA(0, 1), a2 + hstep, voffA);
            PG8_WAIT_L(8); PG8_BAR; PG8_WAIT_L(0); PG8_MMA(0, 0, At, B0); PG8_BAR; PG8_SCHED;
            PG8_LDB(B1, 1, 1); PG8_STAGE(PG8_SB(1, 0), b3, voffB);
            PG8_BAR; PG8_WAIT_L(0); PG8_MMA(0, 1, At, B1); PG8_BAR;
            PG8_LDA(At, 1, 1); PG8_STAGE(PG8_SA(1, 0), a3, voffA);
            PG8_BAR; PG8_WAIT_L(0); PG8_MMA(1, 0, At, B0); PG8_BAR; PG8_SCHED;
            PG8_STAGE(PG8_SB(1, 1), b3 + hstep, voffB);
            PG8_WAIT_V(6); PG8_BAR; PG8_MMA(1, 1, At, B1); PG8_BAR;
            }
        }
        if constexpr (ALIGN_EPI) { if (wr == 0) PG8_BAR; }
        if constexpr (!Epi::AFTER_DRAIN) { E(acc, cur, wr, wc, fr, fq); S.done(cur); }
        if (!has_next) break;
#pragma unroll
        for (int a = 0; a < 2; ++a)
#pragma unroll
            for (int b = 0; b < 2; ++b)
#pragma unroll
                for (int m = 0; m < 4; ++m)
#pragma unroll
                    for (int n = 0; n < 2; ++n) acc[a][b][m][n] = (f32x4){0.f, 0.f, 0.f, 0.f};
        cur = nxt; cA = nA; cB = nB; ++ui; nt = cur.nkt;
        if constexpr (ALIGN_EPI) { if (wr == 1) PG8_BAR; }
    }
    PG8_WAIT_V(0);
    if constexpr (!ALIGN_EPI) { if (wr == 0) PG8_BAR; }
    PG8_BAR;
    if constexpr (Epi::AFTER_DRAIN) { E.fused(acc, cur, wr, wc, fr, fq, lds, wid, lane); S.done(cur); }
#undef PG8_SA
#undef PG8_SB
#undef PG8_STAGE
#undef PG8_LDA
#undef PG8_LDB
#undef PG8_MMA
#undef PG8_WAIT_V
#undef PG8_WAIT_L
#undef PG8_BAR
#undef PG8_SCHED
}
}
namespace pg8 {
__device__ __forceinline__ float silu_mul(float g, float u) { return g * __builtin_amdgcn_rcpf(1.f + __builtin_amdgcn_exp2f(-1.4426950408889634f * g)) * u; }
struct EpiSwiGLU {
    static constexpr bool PERM = true, AFTER_DRAIN = false;
    bf16_t* O; int ldc;
    __device__ __forceinline__ void operator()(const f32x4 (&acc)[2][2][4][2], const Unit& u, int wr, int wc, int fr, int fq) const {
        const int row0 = u.pm * BM + wr * 64 + fr, col0 = u.pn * HALF + wc * 32 + 8 * fq;
#pragma unroll
        for (int ai = 0; ai < 2; ++ai)
#pragma unroll
            for (int m = 0; m < 4; ++m) { bf16_t* rowp = O + (size_t)(row0 + ai * HALF + m * 16) * ldc + col0;
                const f32x4 g0 = acc[ai][0][m][0], g1 = acc[ai][0][m][1], u0 = acc[ai][1][m][0], u1 = acc[ai][1][m][1];
                u32x4 w; w.x = cvt_pk_bf16(silu_mul(g0[0], u0[0]), silu_mul(g0[1], u0[1])); w.y = cvt_pk_bf16(silu_mul(g0[2], u0[2]), silu_mul(g0[3], u0[3]));
                w.z = cvt_pk_bf16(silu_mul(g1[0], u1[0]), silu_mul(g1[1], u1[1])); w.w = cvt_pk_bf16(silu_mul(g1[2], u1[2]), silu_mul(g1[3], u1[3]));
                *(u32x4*)rowp = w; }
    }
};
struct EpiF32 {
    static constexpr bool PERM = false, AFTER_DRAIN = false;
    float* O; int ldc; float* slab; int row0s, rows_s, nkt_full;
    __device__ __forceinline__ void operator()(const f32x4 (&acc)[2][2][4][2], const Unit& u, int wr, int wc, int fr, int fq) const {
        const int row0 = u.pm * BM + wr * 64 + fr, col0 = u.pn * BM + wc * 32 + 4 * fq;
        float* base = O + (size_t)row0 * ldc;
        if (u.nkt != nkt_full) base = slab + ((size_t)(u.kt0 / SPLIT_KT) * rows_s + (row0 - row0s)) * ldc;
#pragma unroll
        for (int ai = 0; ai < 2; ++ai)
#pragma unroll
            for (int m = 0; m < 4; ++m) { float* rowp = base + (size_t)(ai * HALF + m * 16) * ldc + col0;
#pragma unroll
                for (int bj = 0; bj < 2; ++bj)
#pragma unroll
                    for (int n = 0; n < 2; ++n) *(f32x4*)(rowp + bj * HALF + n * 16) = acc[ai][bj][m][n]; }
    }
};
struct EpiWin {
    static constexpr bool PERM = false, AFTER_DRAIN = false;
    bf16_t* QKV; float* PR; float* kout; float* vout; float* kout_s; float* vout_s; float* shift_p; float* shift_s; float qscale; int MPr, SEQr;
    __device__ __forceinline__ void operator()(const f32x4 (&acc)[2][2][4][2], const Unit& u, int wr, int wc, int fr, int fq) const {
        typedef unsigned u32x2v __attribute__((ext_vector_type(2)));
        const int ct = u.pn, row0 = u.pm * BM + wr * 64 + fr, colt = wc * 32 + 4 * fq;
        const bool samp = (u.pm * BM) >= MPr;
#pragma unroll
        for (int ai = 0; ai < 2; ++ai)
#pragma unroll
            for (int m = 0; m < 4; ++m) { const int row = row0 + ai * HALF + m * 16;
#pragma unroll
                for (int bj = 0; bj < 2; ++bj)
#pragma unroll
                    for (int n = 0; n < 2; ++n) { const int c = ct * BM + colt + bj * HALF + n * 16; const f32x4 v = acc[ai][bj][m][n];
                        if (ct < 6) { const float sc = ct < 2 ? qscale : 1.f; u32x2v w; w.x = cvt_pk_bf16(v[0] * sc, v[1] * sc); w.y = cvt_pk_bf16(v[2] * sc, v[3] * sc);
                            *(u32x2v*)(QKV + (size_t)row * 1536 + c) = w;
                            if (ct >= 2) { float* ob = (ct < 4) ? (samp ? kout_s + (size_t)(row - MPr) * 512 : kout + (size_t)row * 512) + (c - 512)
                                                                  : (samp ? vout_s + (size_t)(row - MPr) * 512 : vout + (size_t)row * 512) + (c - 1024);
                                *(f32x4*)ob = v; } }
                        else { const int pc = c - 1536; *(f32x4*)(PR + (size_t)row * 1792 + pc) = v;
                            if (!samp) { if ((row & (SEQr - 1)) == SEQr - 1) *(f32x4*)(shift_p + (size_t)(row / SEQr) * 1792 + pc) = v; }
                            else { const int rs = row - MPr; if ((rs & 3) == 3) *(f32x4*)(shift_s + (size_t)(rs >> 2) * 1792 + pc) = v; } } } }
    }
};
}
#include <hip/hip_bf16.h>
#include <cmath>
namespace attn_body {
using bf16=__hip_bfloat16;
using bf16x8=__attribute__((ext_vector_type(8)))short;
using s16x4=__attribute__((ext_vector_type(4)))short;
using f32x16=__attribute__((ext_vector_type(16)))float;
using u32x4=__attribute__((ext_vector_type(4)))unsigned;
constexpr int SEQ=2048,D=64,PQ=1536,PO=1024;
constexpr int NW=8,QBLK=32,QB=QBLK*NW,KVBLK=64,NQB=SEQ/QB;
constexpr int ATTN_UNIT_ROWS=QB;
__device__ __forceinline__ int crow(int r,int hi){return (r&3)+8*(r>>2)+4*hi;}
#define SBAR() __builtin_amdgcn_sched_barrier(0)
typedef __attribute__((address_space(3))) const float* lds_cfptr;
__device__ __forceinline__ void cbias(f32x16&p0,f32x16&p1,int jb,int qrel,int hi,lds_cfptr R){
  const int nb=qrel-64*(jb-2)-4*hi; lds_cfptr rp=R+(383-nb);
  #pragma unroll
  for(int r=0;r<16;++r){const int off=(r&3)+8*(r>>2); p0[r]+=rp[off]; p1[r]+=rp[off+32];}
}

constexpr int NSLOT=3, SLOTB=8192;
constexpr int LDS_K=0, LDS_V=NSLOT*SLOTB, LDS_WS=2*NSLOT*SLOTB, LDS_OST=LDS_WS+NW*64*4, LDS_BYTES=LDS_OST+NW*4096;
constexpr float C2=0.125f*1.4426950408889634f;
__device__ __forceinline__ void glds16(const void*gsrc,unsigned lds_dst){unsigned keep;
  asm volatile("s_mov_b32 %0, m0\n\ts_mov_b32 m0, %2\n\ts_nop 0\n\tglobal_load_lds_dwordx4 %1, off\n\ts_mov_b32 m0, %0":"=&s"(keep):"v"(gsrc),"s"(lds_dst):"memory");}
__device__ __forceinline__ float max3f(float a,float b,float c){float r;asm("v_max3_f32 %0, %1, %2, %3":"=v"(r):"v"(a),"v"(b),"v"(c));return r;}
__device__ __forceinline__ float max2f(float a,float b){float r;asm("v_max_f32_e32 %0, %1, %2":"=v"(r):"v"(a),"v"(b));return r;}
__device__ __forceinline__ float fadd_s(float a,float b){float r;asm("v_add_f32_e32 %0, %1, %2":"=v"(r):"v"(a),"v"(b));return r;}
__device__ __forceinline__ float fsub_s(float a,float b){float r;asm("v_sub_f32_e32 %0, %1, %2":"=v"(r):"v"(a),"v"(b));return r;}
typedef float f32x2_t __attribute__((ext_vector_type(2))); typedef __bf16 bf16x2_t __attribute__((ext_vector_type(2)));
__device__ __forceinline__ unsigned cvtpk_s(float lo,float hi){f32x2_t v={lo,hi};bf16x2_t b=__builtin_convertvector(v,bf16x2_t);return __builtin_bit_cast(unsigned,b);}
#define WAIT_BAR(N) asm volatile("s_waitcnt vmcnt(" #N ") lgkmcnt(0)\n\ts_barrier":::"memory")

__device__ __forceinline__ void qkt(f32x16&p0,f32x16&p1,const char*Kslot,const bf16x8*qr,const f32x16&negm,int r32,int hi){
  const char*kb=Kslot+hi*1024+r32*16;
  #pragma unroll
  for(int d0=0;d0<4;++d0){
    const bf16x8 b0=*reinterpret_cast<const bf16x8*>(kb+d0*2048);
    const bf16x8 b1=*reinterpret_cast<const bf16x8*>(kb+d0*2048+512);
    if(d0==0){p0=__builtin_amdgcn_mfma_f32_32x32x16_bf16(b0,qr[0],negm,0,0,0);p1=__builtin_amdgcn_mfma_f32_32x32x16_bf16(b1,qr[0],negm,0,0,0);}
    else{p0=__builtin_amdgcn_mfma_f32_32x32x16_bf16(b0,qr[d0],p0,0,0,0);p1=__builtin_amdgcn_mfma_f32_32x32x16_bf16(b1,qr[d0],p1,0,0,0);}}
}
typedef __attribute__((address_space(3))) const char* lds_cptr;
typedef short v4i16_t __attribute__((ext_vector_type(4)));
__device__ __forceinline__ void kload8(bf16x8*kf,lds_cptr kp){
  kf[0]=*(const __attribute__((address_space(3))) bf16x8*)(kp);      kf[1]=*(const __attribute__((address_space(3))) bf16x8*)(kp+512);
  kf[2]=*(const __attribute__((address_space(3))) bf16x8*)(kp+2048); kf[3]=*(const __attribute__((address_space(3))) bf16x8*)(kp+2560);
  kf[4]=*(const __attribute__((address_space(3))) bf16x8*)(kp+4096); kf[5]=*(const __attribute__((address_space(3))) bf16x8*)(kp+4608);
  kf[6]=*(const __attribute__((address_space(3))) bf16x8*)(kp+6144); kf[7]=*(const __attribute__((address_space(3))) bf16x8*)(kp+6656);
}
__device__ __forceinline__ void kload2(bf16x8*kf,lds_cptr kp,int j){ kf[2*j]=*(const __attribute__((address_space(3))) bf16x8*)(kp+j*2048); kf[2*j+1]=*(const __attribute__((address_space(3))) bf16x8*)(kp+j*2048+512); }
__device__ __forceinline__ s16x4 vtr(lds_cptr p){ return __builtin_bit_cast(s16x4,__builtin_amdgcn_ds_read_tr16_b64_v4i16((__attribute__((address_space(3))) v4i16_t*)p)); }
__device__ __forceinline__ float rowmax(const f32x16&p0,const f32x16&p1){
  float a=max3f(p0[0],p0[1],p1[0]),b=max3f(p0[2],p0[3],p1[1]);a=max3f(a,p1[2],p1[3]);
  #pragma unroll
  for(int r=4;r<16;r+=4){a=max3f(a,p0[r],p0[r+1]);b=max3f(b,p0[r+2],p0[r+3]);a=max3f(a,p1[r],p1[r+1]);b=max3f(b,p1[r+2],p1[r+3]);}
  const float m=max2f(a,b);
  auto rr=__builtin_amdgcn_permlane32_swap(__float_as_uint(m),__float_as_uint(m),false,false);
  return max2f(__uint_as_float(rr[0]),__uint_as_float(rr[1]));
}
__device__ __forceinline__ void pv(f32x16*o,int vb,bf16x8 pa0,bf16x8 pa1,bf16x8 pa2,bf16x8 pa3){
  #pragma unroll
  for(int d0=0;d0<2;++d0){s16x4 lo[4],hi[4];
    #pragma unroll
    for(int ks=0;ks<4;++ks){
      asm volatile("ds_read_b64_tr_b16 %0,%1 offset:%c2":"=&v"(lo[ks]):"v"(vb),"i"(d0*4096+ks*1024):"memory");
      asm volatile("ds_read_b64_tr_b16 %0,%1 offset:%c2":"=&v"(hi[ks]):"v"(vb),"i"(d0*4096+ks*1024+512):"memory");}
    asm volatile("s_waitcnt lgkmcnt(0)":::"memory");SBAR();
    #define PK(k) (bf16x8){lo[k][0],lo[k][1],lo[k][2],lo[k][3],hi[k][0],hi[k][1],hi[k][2],hi[k][3]}
    o[d0]=__builtin_amdgcn_mfma_f32_32x32x16_bf16(pa0,PK(0),o[d0],0,0,0);
    o[d0]=__builtin_amdgcn_mfma_f32_32x32x16_bf16(pa1,PK(1),o[d0],0,0,0);
    o[d0]=__builtin_amdgcn_mfma_f32_32x32x16_bf16(pa2,PK(2),o[d0],0,0,0);
    o[d0]=__builtin_amdgcn_mfma_f32_32x32x16_bf16(pa3,PK(3),o[d0],0,0,0);
    #undef PK
  }
}

#ifndef ATTN_STORE16
#define ATTN_STORE16(p,v) (*(u32x4*)(p)=(v))
#endif
template<int THRL> __device__ __forceinline__ void attn_unit(int b,int qb,const bf16*Qc,const bf16*__restrict__ Kc,const bf16*__restrict__ Vc,bf16*Oc,lds_cfptr lutR,char*shm){
  const int tid=threadIdx.x,lane=tid&63,r32=lane&31,hi=lane>>5; const int wid=__builtin_amdgcn_readfirstlane(tid>>6);
  const long rowbase=(long)b*SEQ; const int q0=qb*QB;
  const bf16*Qw=Qc+(rowbase+q0+wid*QBLK)*PQ;
  const bf16*Kh=Kc+rowbase*PQ,*Vh=Vc+rowbase*PQ;
  const unsigned lds0=(unsigned)(uintptr_t)shm;
  float*wsf=(float*)(shm+LDS_WS)+wid*64;
  const bf16*ksrc=Kh+(long)lane*PQ+wid*8;
  const bf16*vsrc=Vh+(long)(16*(wid&3)+(lane>>2))*PQ+(wid>>2)*32+(lane&3)*8;
  const unsigned kdst=lds0+LDS_K+wid*1024, vdst=lds0+LDS_V+wid*1024;
  #define DMA_K(t,slot) glds16(ksrc+(long)(t)*KVBLK*PQ,(unsigned)__builtin_amdgcn_readfirstlane(kdst+(slot)))
  #define DMA_V(t,slot) glds16(vsrc+(long)(t)*KVBLK*PQ,(unsigned)__builtin_amdgcn_readfirstlane(vdst+(slot)))
  const int vb0=(int)(lds0+LDS_V)+((lane>>4)&1)*32+(lane&3)*8+(4*hi+((lane&15)>>2))*64;
  const char*Kbase=shm+LDS_K; bf16x8 kf[8];
  const lds_cptr shm3=(lds_cptr)shm; const lds_cptr kp0=shm3+LDS_K+hi*1024+r32*16; const lds_cptr vp0=shm3+LDS_V+((lane>>4)&1)*32+(lane&3)*8+(4*hi+((lane&15)>>2))*64;
  const int NT=(q0+QB)/KVBLK;
  DMA_K(0,0);DMA_V(0,0);DMA_K(1,SLOTB);
  bf16x8 qr[4];
  #pragma unroll
  for(int d0=0;d0<4;++d0)qr[d0]=*reinterpret_cast<const bf16x8*>(&Qw[(long)r32*PQ+d0*16+hi*8]);
  float mhat=0.f,l_reg=0.f;f32x16 o[2];o[0]=f32x16{};o[1]=f32x16{};f32x16 negm=f32x16{};asm volatile("":"+v"(negm));
  const int qrel=wid*QBLK+r32;
  #define CMASK(P0,P1,t) do{int jb_=(t)-(NT-6); if(jb_>=0)cbias(P0,P1,jb_,qrel,hi,lutR);}while(0)
  bool resc=false;
  #define START(P0,P1) do{ const float rm=rowmax(P0,P1); resc=false; \
    { const float dl=rm; mhat=fadd_s(mhat,dl); \
      _Pragma("unroll") for(int r=0;r<16;++r){P0[r]=fsub_s(P0[r],dl);P1[r]=fsub_s(P1[r],dl);} \
      _Pragma("unroll") for(int r=0;r<16;++r)negm[r]=-mhat; asm volatile("":"+v"(negm)); } \
    _Pragma("unroll") for(int r=0;r<16;++r)P0[r]=__builtin_amdgcn_exp2f(P0[r]); }while(0)
  #define RESC() do{ if(resc){ asm volatile("s_waitcnt lgkmcnt(0)":::"memory"); \
      _Pragma("unroll") for(int d_=0;d_<2;++d_) _Pragma("unroll") for(int r=0;r<16;++r)o[d_][r]*=wsf[crow(r,hi)]; } }while(0)
  f32x16 pA0,pA1,pB0,pB1;
  int sl_prev=0,sl_cur=0,sl_next=SLOTB;
  #define ROT() do{sl_prev=sl_cur;sl_cur=sl_next;sl_next=(sl_next==(NSLOT-1)*SLOTB)?0:sl_next+SLOTB;}while(0)
  DMA_K(2,2*SLOTB);
  WAIT_BAR(3);
  qkt(pA0,pA1,Kbase,qr,negm,r32,hi);asm volatile("s_nop 15\n\ts_nop 7":"+v"(pA0),"+v"(pA1));CMASK(pA0,pA1,0);
  START(pA0,pA1);
  _Pragma("unroll") for(int r=0;r<16;++r)pA1[r]=__builtin_amdgcn_exp2f(pA1[r]);
  WAIT_BAR(0);
  DMA_K(3,0);DMA_V(1,SLOTB);
  ROT();
  kload8(kf,kp0+sl_cur);
  WAIT_BAR(2);
  s16x4 vlo[8],vhi[8]; u32x4 pw0,pw1,pw2,pw3;
  #define PKW(P,B) cvtpk_s(P[B],P[B+1])
  #define PAF(k) __builtin_bit_cast(bf16x8,pw##k)
  #define VFR(i) (bf16x8){vlo[i][0],vlo[i][1],vlo[i][2],vlo[i][3],vhi[i][0],vhi[i][1],vhi[i][2],vhi[i][3]}
  #define PIN(x) asm volatile("":"+v"(x))
  #define MX3(a,b,c) __builtin_fmaxf(__builtin_fmaxf((a),(b)),(c))
  #define GAPA(MF,A0,A1,A2,A3,W0,W1,PW) do{ MF; sacc+=A0; sacc+=A1; sacc+=A2; sacc+=A3; PIN(sacc); W0; W1; PIN(PW); SBAR(); }while(0)
  #define EX(v) __builtin_amdgcn_exp2f(v)
  #define GAPB(MF,X,B) do{ MF; X[B]=EX(X[B]); X[B+1]=EX(X[B+1]); X[B+2]=EX(X[B+2]); X[B+3]=EX(X[B+3]); PIN(X); SBAR(); }while(0)
  #define VRD(i) do{ vlo[i]=vtr(vp_+(((i)>>2)*4096+((i)&3)*1024)); vhi[i]=vtr(vp_+(((i)>>2)*4096+((i)&3)*1024+512)); }while(0)
  #define KRD(G,j) do{ if(G){ kload2(kf,kp0+sl_next,j); SBAR(); } }while(0)
  #define STEP(C0,C1,P0,P1,t,GK,GV,GL) do{ SBAR(); \
    const lds_cptr vp_=vp0+sl_prev; \
    VRD(0); SBAR(); float sacc=(P0[0]+P0[1]); \
    GAPA(C0=__builtin_amdgcn_mfma_f32_32x32x16_bf16(kf[0],qr[0],negm,0,0,0), P0[2],P0[3],P0[4],P0[5],     pw0[0]=PKW(P0,0), pw0[1]=PKW(P0,2), pw0); \
    VRD(4); SBAR(); GAPA(C1=__builtin_amdgcn_mfma_f32_32x32x16_bf16(kf[1],qr[0],negm,0,0,0), P0[6],P0[7],P0[8],P0[9],     pw0[2]=PKW(P0,4), pw0[3]=PKW(P0,6), pw0); \
    VRD(1); SBAR(); GAPA(C0=__builtin_amdgcn_mfma_f32_32x32x16_bf16(kf[2],qr[1],C0,0,0,0),   P0[10],P0[11],P0[12],P0[13], pw1[0]=PKW(P0,8), pw1[1]=PKW(P0,10), pw1); \
    VRD(5); SBAR(); GAPA(C1=__builtin_amdgcn_mfma_f32_32x32x16_bf16(kf[3],qr[1],C1,0,0,0),   P0[14],P0[15],P1[0],P1[1],   pw1[2]=PKW(P0,12),pw1[3]=PKW(P0,14), pw1); \
    VRD(2); SBAR(); GAPA(C0=__builtin_amdgcn_mfma_f32_32x32x16_bf16(kf[4],qr[2],C0,0,0,0),   P1[2],P1[3],P1[4],P1[5],     pw2[0]=PKW(P1,0), pw2[1]=PKW(P1,2), pw2); \
    VRD(6); SBAR(); GAPA(C1=__builtin_amdgcn_mfma_f32_32x32x16_bf16(kf[5],qr[2],C1,0,0,0),   P1[6],P1[7],P1[8],P1[9],     pw2[2]=PKW(P1,4), pw2[3]=PKW(P1,6), pw2); \
    VRD(3); SBAR(); GAPA(C0=__builtin_amdgcn_mfma_f32_32x32x16_bf16(kf[6],qr[3],C0,0,0,0),   P1[10],P1[11],P1[12],P1[13], pw3[0]=PKW(P1,8), pw3[1]=PKW(P1,10), pw3); \
    VRD(7); SBAR(); GAPA(C1=__builtin_amdgcn_mfma_f32_32x32x16_bf16(kf[7],qr[3],C1,0,0,0),   P1[14],P1[15],0.f,0.f,       pw3[2]=PKW(P1,12),pw3[3]=PKW(P1,14), pw3); \
    l_reg+=sacc; \
    if(GK){DMA_K((t)+3,sl_cur);} if(GV){DMA_V((t)+1,sl_next);} \
    CMASK(C0,C1,t); \
    { float a=MX3(C0[0],C0[1],C1[0]),b=MX3(C0[2],C0[3],C1[1]); a=MX3(a,C1[2],C1[3]); \
      _Pragma("unroll") for(int r=4;r<16;r+=4){a=MX3(a,C0[r],C0[r+1]);b=MX3(b,C0[r+2],C0[r+3]);a=MX3(a,C1[r],C1[r+1]);b=MX3(b,C1[r+2],C1[r+3]);} \
      float rm=__builtin_fmaxf(a,b); { auto rr=__builtin_amdgcn_permlane32_swap(__float_as_uint(rm),__float_as_uint(rm),false,false); rm=__builtin_fmaxf(__uint_as_float(rr[0]),__uint_as_float(rr[1])); } \
      resc=false; \
      if(__builtin_expect(__any(rm>(float)THRL),0)){ const float dl=__builtin_fmaxf(rm,0.f); mhat+=dl; \
        _Pragma("unroll") for(int r=0;r<16;++r){C0[r]-=dl;C1[r]-=dl;} \
        _Pragma("unroll") for(int r=0;r<16;++r)negm[r]=-mhat; asm volatile("":"+v"(negm)); \
        const float f=__builtin_amdgcn_exp2f(-dl); l_reg*=f; if(hi==0)wsf[r32]=f; resc=true; } } \
    SBAR(); \
    GAPB(o[0]=__builtin_amdgcn_mfma_f32_32x32x16_bf16(PAF(0),VFR(0),o[0],0,0,0), C0,0); \
    GAPB(o[1]=__builtin_amdgcn_mfma_f32_32x32x16_bf16(PAF(0),VFR(4),o[1],0,0,0), C0,4); \
    KRD(GL,0); GAPB(o[0]=__builtin_amdgcn_mfma_f32_32x32x16_bf16(PAF(1),VFR(1),o[0],0,0,0), C0,8); \
    KRD(GL,1); GAPB(o[1]=__builtin_amdgcn_mfma_f32_32x32x16_bf16(PAF(1),VFR(5),o[1],0,0,0), C0,12); \
    KRD(GL,2); GAPB(o[0]=__builtin_amdgcn_mfma_f32_32x32x16_bf16(PAF(2),VFR(2),o[0],0,0,0), C1,0); \
    KRD(GL,3); GAPB(o[1]=__builtin_amdgcn_mfma_f32_32x32x16_bf16(PAF(2),VFR(6),o[1],0,0,0), C1,4); \
    GAPB(o[0]=__builtin_amdgcn_mfma_f32_32x32x16_bf16(PAF(3),VFR(3),o[0],0,0,0), C1,8); \
    GAPB(o[1]=__builtin_amdgcn_mfma_f32_32x32x16_bf16(PAF(3),VFR(7),o[1],0,0,0), C1,12); \
    }while(0)
  int t=1;
  #undef CMASK
  #define CMASK(P0,P1,t) do{}while(0)
  for(;t+7<NT;t+=2){
    STEP(pB0,pB1,pA0,pA1,t,true,true,true);     WAIT_BAR(2); RESC(); ROT();
    STEP(pA0,pA1,pB0,pB1,t+1,true,true,true);   WAIT_BAR(2); RESC(); ROT();
  }
  #undef CMASK
  #define CMASK(P0,P1,t) do{int jb_=(t)-(NT-6); if(jb_>=0)cbias(P0,P1,jb_,qrel,hi,lutR);}while(0)
  #define ENDW(tt) do{ if((tt)+3<NT){WAIT_BAR(2);} else if((tt)+2<NT){WAIT_BAR(1);} else {WAIT_BAR(0);} }while(0)
  for(;t+1<NT;t+=2){
    STEP(pB0,pB1,pA0,pA1,t,(t+3<NT),(t+1<NT),(t+1<NT));       ENDW(t);   RESC(); ROT();
    STEP(pA0,pA1,pB0,pB1,t+1,(t+4<NT),(t+2<NT),(t+2<NT));     ENDW(t+1); RESC(); ROT();
  }
  STEP(pB0,pB1,pA0,pA1,NT-1,false,false,false); RESC();
  { float sacc=pB0[0]+pB0[1]; _Pragma("unroll") for(int r=2;r<16;++r)sacc+=pB0[r]; _Pragma("unroll") for(int r=0;r<16;++r)sacc+=pB1[r]; l_reg+=sacc;
    pw0=(u32x4){PKW(pB0,0),PKW(pB0,2),PKW(pB0,4),PKW(pB0,6)};pw1=(u32x4){PKW(pB0,8),PKW(pB0,10),PKW(pB0,12),PKW(pB0,14)};pw2=(u32x4){PKW(pB1,0),PKW(pB1,2),PKW(pB1,4),PKW(pB1,6)};pw3=(u32x4){PKW(pB1,8),PKW(pB1,10),PKW(pB1,12),PKW(pB1,14)};
    SBAR(); pv(o,vb0+sl_cur,PAF(0),PAF(1),PAF(2),PAF(3)); }
  #undef PKW
  #undef PAF
  #undef VFR
  #undef PIN
  #undef MX3
  #undef GAPA
  #undef GAPB
  #undef EX
  #undef VRD
  #undef KRD
  #undef STEP
  #undef ENDW
  {auto rr=__builtin_amdgcn_permlane32_swap(__float_as_uint(l_reg),__float_as_uint(l_reg),false,false);l_reg=__uint_as_float(rr[0])+__uint_as_float(rr[1]);}
  if(hi==0)wsf[32+r32]=l_reg;asm volatile("s_waitcnt lgkmcnt(0)":::"memory");
  float rli[16];
  #pragma unroll
  for(int r=0;r<16;++r)rli[r]=__builtin_amdgcn_rcpf(wsf[32+crow(r,hi)]);
  bf16*Ow=Oc+(rowbase+q0+wid*QBLK)*PO;
  { bf16*stg=(bf16*)(shm+LDS_OST)+wid*2048;
    #pragma unroll
    for(int r=0;r<16;++r){const int orow=crow(r,hi);
      #pragma unroll
      for(int d0=0;d0<2;++d0)stg[orow*64+d0*32+r32]=__float2bfloat16(o[d0][r]*rli[r]);}
    asm volatile("s_waitcnt lgkmcnt(0)":::"memory");
    #pragma unroll
    for(int i=0;i<4;++i){const int row=i*8+(lane>>3),ch=lane&7; const u32x4 v=*(const u32x4*)(stg+row*64+ch*8); ATTN_STORE16(Ow+(long)row*PO+ch*8,v);} }
  asm volatile("s_waitcnt lgkmcnt(0)\n\ts_barrier":::"memory");
  #undef DMA_K
  #undef DMA_V
  #undef CMASK
  #undef START
  #undef RESC
  #undef ROT
}
constexpr int ATTN_LDS_BYTES=LDS_BYTES;
#undef SBAR
#undef WAIT_BAR
}
#define GAS __attribute__((address_space(1)))
#define LAS __attribute__((address_space(3)))
typedef unsigned short bf16;
typedef unsigned v4u __attribute__((ext_vector_type(4)));
typedef float f32x4 __attribute__((ext_vector_type(4)));
typedef short bf16x8 __attribute__((ext_vector_type(8)));
typedef GAS unsigned gu32;
typedef GAS unsigned long long gu64;
#define RLX_AGENT __ATOMIC_RELAXED, __HIP_MEMORY_SCOPE_AGENT
#define LDS_WAIT() asm volatile("s_waitcnt lgkmcnt(0)" ::: "memory")
#define VM_WAIT() asm volatile("s_waitcnt vmcnt(0)" ::: "memory")
__device__ __forceinline__ unsigned long long rt() { return __builtin_amdgcn_s_memrealtime(); }
__device__ __forceinline__ unsigned f2bf(float f) { unsigned u = __builtin_bit_cast(unsigned, f); return (u + 0x7fffu + ((u >> 16) & 1u)) >> 16; }
__device__ __forceinline__ unsigned pk2(float lo, float hi) { return f2bf(lo) | (f2bf(hi) << 16); }

#define XB_TMO      128
#define XB_XCNT(j)  (256  + 64 * (j))
#define XB_XSUB(j)  (1280 + 64 * (j))
#define XB_XGEN(j)  (2304 + 64 * (j))
#define XB_TOP      3328
#define XB_TOPGEN   3392
#define XCD_BAR_WORDS 3456
#define XB_SPIN_CAP (1u << 18)

__device__ __forceinline__ unsigned xb_ld(unsigned* p)              { return __hip_atomic_load(p, __ATOMIC_RELAXED, __HIP_MEMORY_SCOPE_AGENT); }
__device__ __forceinline__ unsigned xb_add(unsigned* p, unsigned v) { return __hip_atomic_fetch_add(p, v, __ATOMIC_RELAXED, __HIP_MEMORY_SCOPE_AGENT); }
__device__ __forceinline__ unsigned xb_xcc_id() { return (unsigned)__builtin_amdgcn_s_getreg((3 << 11) | 20) & 0xFu; }
#define XB_SPIN(cond, bar) do { unsigned _sp = 0; while (cond) { __builtin_amdgcn_s_sleep(1); \
    if ((++_sp & 255u) == 0u) { if (xb_ld(&(bar)[XB_TMO])) break; if (_sp > XB_SPIN_CAP) { atomicAdd(&(bar)[XB_TMO], 1u); break; } } } } while (0)

struct XcdBarrier {
    unsigned* bar; unsigned x;
    volatile LAS unsigned* st;
};

__device__ __forceinline__ XcdBarrier xcd_barrier_post(unsigned* bar, volatile LAS unsigned* st) {
    XcdBarrier b; b.bar = bar; b.x = xb_xcc_id(); b.st = st;
    if (threadIdx.x == 0) (void)xb_add(&bar[XB_XCNT(b.x)], 1u);
    return b;
}
__device__ __forceinline__ void xcd_barrier_complete(unsigned* bar, unsigned x, unsigned& nloc, unsigned& nx) {
    const unsigned G = gridDim.x * gridDim.y * gridDim.z;
    unsigned sum, cnt, mine, sp = 0u;
    for (;;) {
        sum = 0u; cnt = 0u; mine = 0u;
#pragma unroll
        for (unsigned j = 0; j < 16; ++j) { const unsigned c = xb_ld(&bar[XB_XCNT(j)]); sum += c; cnt += (c > 0u) ? 1u : 0u; mine = (j == x) ? c : mine; }
        if (sum == G) break;
        __builtin_amdgcn_s_sleep(1);
        if ((++sp & 255u) == 0u) { if (xb_ld(&bar[XB_TMO])) break; if (sp > XB_SPIN_CAP) { atomicAdd(&bar[XB_TMO], 1u); break; } }
    }
    nloc = mine > 0u ? mine : 1u; nx = cnt > 0u ? cnt : 1u;
}

__device__ __forceinline__ void xcd_barrier(const XcdBarrier& b) {
    asm volatile("s_waitcnt vmcnt(0)" ::: "memory");
    __syncthreads();
    if (threadIdx.x == 0) {
        unsigned* bar = b.bar;
        __builtin_amdgcn_s_waitcnt(0);
        unsigned nloc = b.st[0], nx = b.st[1];
        if (nloc == 0u) { xcd_barrier_complete(bar, b.x, nloc, nx); b.st[0] = nloc; b.st[1] = nx; }
        const unsigned old = xb_add(&bar[XB_XSUB(b.x)], 1u);
        const unsigned gen = old / nloc;
        if (old + 1u == (gen + 1u) * nloc) {
            __builtin_amdgcn_fence(__ATOMIC_RELEASE, "agent");
            asm volatile("s_waitcnt vmcnt(0)" ::: "memory");
            const unsigned og = xb_add(&bar[XB_TOP], 1u);
            const unsigned tg = og / nx;
            if (og + 1u == (tg + 1u) * nx) xb_add(&bar[XB_TOPGEN], 1u);
            else XB_SPIN(xb_ld(&bar[XB_TOPGEN]) == tg, bar);
            __builtin_amdgcn_fence(__ATOMIC_ACQUIRE, "agent");
            xb_add(&bar[XB_XGEN(b.x)], 1u);
            asm volatile("s_waitcnt vmcnt(0)" ::: "memory");
        } else {
            XB_SPIN(xb_ld(&bar[XB_XGEN(b.x)]) == gen, bar);
            __builtin_amdgcn_fence(__ATOMIC_ACQUIRE, "agent");
            asm volatile("s_waitcnt vmcnt(0)" ::: "memory");
        }
    }
    __syncthreads();
}
constexpr int NWAVES = 8;
constexpr int DM = 1024, NB = 8, SEQ = 2048, MP = NB * SEQ, DECB = 128, DECS = 4, MS = DECB * DECS, M = MP + MS;
constexpr int RH = 8, RW = 512, RCOLS = 1792, PCOLS = 3328, DFF = 2816, NPG = 16, PAGE = 128;
constexpr float NORM_EPS = 1e-6f, SUBLN_EPS = 1e-5f, GN_EPS = 64e-5f, LAM_INIT = 0.2f;
constexpr float LOG2E = 1.4426950408889634f;
constexpr float QSCALE = 0.125f * LOG2E;
#ifndef MK_PER_PHASE
#define MK_PER_PHASE 0
#endif
constexpr int NPHASE = 13;
constexpr size_t OUT_Y = 0, OUT_KP = (size_t)M * DM, OUT_VP = OUT_KP + (size_t)MP * 512, OUT_KS = OUT_VP + (size_t)MP * 512, OUT_VS = OUT_KS + (size_t)MS * 512,
                 OUT_WP = OUT_VS + (size_t)MS * 512, OUT_WS = OUT_WP + (size_t)NB * RH * 4096, OUT_SP = OUT_WS + (size_t)DECB * RH * 4096, OUT_SS = OUT_SP + (size_t)NB * RCOLS, OUT_END = OUT_SS + (size_t)DECB * RCOLS;
constexpr size_t MiB = 1u << 20;
constexpr size_t WS_CTL = 0, CTL_ZERO_BYTES = 1 * MiB, WS_ZERO = 512 * 1024;
constexpr size_t WS_FF1IN = 2 * MiB, WS_FF1OUT = 14 * MiB, WS_FF2IN = 20 * MiB, WS_FF2OUT = 32 * MiB, WS_WIN = 38 * MiB, WS_WOUT = 45 * MiB, WS_LORA = 47 * MiB;
constexpr size_t WS_XN = 48 * MiB, WS_H = 82 * MiB, WS_F = 174 * MiB, WS_HRES = 240 * MiB, WS_QKV = 306 * MiB, WS_PR = 356 * MiB, WS_SI = 472 * MiB, WS_G = 670 * MiB,
                 WS_Y = 703 * MiB, WS_O = 736 * MiB, WS_XM = 768 * MiB, WS_BONUS = 801 * MiB, WS_SLAB = 802 * MiB, WS_DPO = 826 * MiB, WS_DPM = 843 * MiB, WS_END = 844 * MiB;
static_assert(WS_FF1IN + (size_t)2 * DFF * DM * 2 <= WS_FF1OUT && WS_FF1OUT + (size_t)DM * DFF * 2 <= WS_FF2IN && WS_FF2IN + (size_t)2 * DFF * DM * 2 <= WS_FF2OUT && WS_FF2OUT + (size_t)DM * DFF * 2 <= WS_WIN, "ws map 1");
static_assert(WS_WIN + (size_t)PCOLS * DM * 2 <= WS_WOUT && WS_WOUT + (size_t)DM * DM * 2 <= WS_LORA && WS_LORA + 256 * 1024 <= WS_XN && WS_XN + (size_t)M * DM * 2 <= WS_H && WS_H + (size_t)M * DFF * 2 <= WS_F, "ws map 2");
static_assert(WS_F + (size_t)M * DM * 4 <= WS_HRES && WS_HRES + (size_t)M * DM * 4 <= WS_QKV && WS_QKV + (size_t)M * 1536 * 2 <= WS_PR && WS_PR + (size_t)M * RCOLS * 4 <= WS_SI && WS_SI + (size_t)M * RH * 384 * 4 <= WS_G, "ws map 3");
static_assert(WS_G + (size_t)M * 512 * 4 <= WS_Y && WS_Y + (size_t)M * 512 * 4 <= WS_O && WS_O + (size_t)MP * 1024 * 2 <= WS_XM && WS_XM + (size_t)M * DM * 2 <= WS_BONUS && WS_BONUS + (size_t)M * RH * 4 <= WS_END, "ws map 4");
constexpr size_t SI_S0 = (size_t)NB * RH * SEQ * 384;
constexpr int CW_TMO = 0, CW_CODE = 1, CW_BAR = 4096;
static_assert((CW_BAR + XCD_BAR_WORDS) * 4 <= (int)WS_ZERO, "CTL words");
constexpr int RING_OFF = 0, RING_BYTES = 131072, LDSCTL_OFF = RING_BYTES, MISC_OFF = LDSCTL_OFF + 320, LDS_BYTES = 147456;
constexpr int LUTR_OFF = LDSCTL_OFF + 512;
constexpr int LUTD_OFF = LUTR_OFF + 4 * 640 * 4;
static_assert(attn_body::ATTN_LDS_BYTES <= RING_BYTES && LUTD_OFF + 4 * 128 * 4 <= LDS_BYTES && MISC_OFF + 128 <= LUTR_OFF, "LDS map");

struct Frame {
    LAS unsigned char* lds; volatile LAS unsigned* MISC; gu32* ctl;
    int tid, lane, wave, vcu, G;
    const float *x_p, *x_s, *cache_k, *cache_v; const int* page_table; const float *state_wkv, *state_shift, *gains, *ff1_in, *ff1_out, *ff2_in, *ff2_out, *w_in, *w_out, *rel_tab;
    const float *lq1, *lk1, *lq2, *lk2, *subln, *mu, *w0, *w2, *a0, *a2, *g2, *kkp, *ka, *rk, *gn_w, *gn_b;
    float* out;
    unsigned char* ws;
};
typedef float f32x2 __attribute__((ext_vector_type(2)));
__device__ __forceinline__ float wave_sum(float v) {
#pragma unroll
    for (int o = 1; o < 64; o <<= 1) v += __shfl_xor(v, o);
    return v;
}
template <int CTRL> __device__ __forceinline__ float dpp_mov(float x) { return __builtin_bit_cast(float, __builtin_amdgcn_update_dpp(0, __builtin_bit_cast(int, x), CTRL, 0xF, 0xF, true)); }
__device__ __forceinline__ float red16(float x) {
    x += dpp_mov<0xB1>(x); x += dpp_mov<0x4E>(x); x += dpp_mov<0x141>(x); x += dpp_mov<0x140>(x); return x; }
__device__ __forceinline__ float red8(float x) { x += dpp_mov<0xB1>(x); x += dpp_mov<0x4E>(x); x += dpp_mov<0x141>(x); return x; }
__device__ __forceinline__ float xsum16(float x) { auto rr = __builtin_amdgcn_permlane16_swap(__float_as_uint(x), __float_as_uint(x), false, false); return __uint_as_float(rr[0]) + __uint_as_float(rr[1]); }
__device__ __forceinline__ float xsum32(float x) { auto rr = __builtin_amdgcn_permlane32_swap(__float_as_uint(x), __float_as_uint(x), false, false); return __uint_as_float(rr[0]) + __uint_as_float(rr[1]); }
__device__ __forceinline__ float xmax16(float x) { auto rr = __builtin_amdgcn_permlane16_swap(__float_as_uint(x), __float_as_uint(x), false, false); return fmaxf(__uint_as_float(rr[0]), __uint_as_float(rr[1])); }
__device__ __forceinline__ float xmax32(float x) { auto rr = __builtin_amdgcn_permlane32_swap(__float_as_uint(x), __float_as_uint(x), false, false); return fmaxf(__uint_as_float(rr[0]), __uint_as_float(rr[1])); }
__device__ __forceinline__ float red32(float x) { return xsum16(red16(x)); }
__device__ __forceinline__ bf16x8 pack8(const float* v) { v4u w; w.x = pg8::cvt_pk_bf16(v[0], v[1]); w.y = pg8::cvt_pk_bf16(v[2], v[3]); w.z = pg8::cvt_pk_bf16(v[4], v[5]); w.w = pg8::cvt_pk_bf16(v[6], v[7]); return __builtin_bit_cast(bf16x8, w); }
__device__ __forceinline__ float sigm(float x) { return __builtin_amdgcn_rcpf(1.f + __builtin_amdgcn_exp2f(-LOG2E * x)); }
__device__ __forceinline__ float tanh_f(float x) { return 1.f - 2.f * __builtin_amdgcn_rcpf(1.f + __builtin_amdgcn_exp2f(2.f * LOG2E * x)); }
__device__ __forceinline__ float compute_lam(const Frame& F) {
    const float d1 = wave_sum(F.lq1[F.lane] * F.lk1[F.lane]), d2 = wave_sum(F.lq2[F.lane] * F.lk2[F.lane]);
    return __expf(d1) - __expf(d2) + LAM_INIT;
}
__device__ __forceinline__ float bias_delta(const float* tab, int n, int h) {
    int bucket;
    if (n < 16) bucket = n;
    else { const int lg = 16 + (int)(logf((float)n / 16.0f) / 2.0794415416798357f * 16.0f); bucket = lg < 31 ? lg : 31; }
    return (tab[bucket * 4 + h] - tab[31 * 4 + h]) * LOG2E;
}

__device__ __forceinline__ void p0_transpose_item(const float* W, int K, int N, bf16* WT, int dst_row0, LAS float* scr, int k0, int n0, int lane) {
#pragma unroll 8
    for (int i = 0; i < 32; ++i) { const int kk = 2 * i + (lane >> 5); scr[kk * 33 + (lane & 31)] = W[(size_t)(k0 + kk) * N + n0 + (lane & 31)]; }
    LDS_WAIT(); asm volatile("" ::: "memory");
    const int c = lane & 7;
#pragma unroll
    for (int j = 0; j < 4; ++j) { const int n = (lane >> 3) + 8 * j; const LAS float* s = scr + (8 * c) * 33 + n;
        v4u o; o.x = pk2(s[0 * 33], s[1 * 33]); o.y = pk2(s[2 * 33], s[3 * 33]); o.z = pk2(s[4 * 33], s[5 * 33]); o.w = pk2(s[6 * 33], s[7 * 33]);
        *(GAS v4u*)(WT + (size_t)(dst_row0 + n) * K + k0 + 8 * c) = o; }
    LDS_WAIT(); asm volatile("" ::: "memory");
}
__device__ __forceinline__ const float* xrow_ptr(const Frame& F, int m) { return m < MP ? F.x_p + (size_t)m * DM : F.x_s + (size_t)(m - MP) * DM; }
__device__ __forceinline__ void p0_prologue(Frame& F) {
    LAS float* scr = (LAS float*)(F.lds + RING_OFF + F.wave * 16384);
    const int gw = F.vcu * NWAVES + F.wave, NGW = F.G * NWAVES;
    constexpr int I_FI = (DM / 64) * (2 * DFF / 32), I_FO = (DFF / 64) * (DM / 32), I_WI = (DM / 64) * (PCOLS / 32), I_WO = (DM / 64) * (DM / 32), I_L64 = 16, I_L128 = 32;
    constexpr int NITEMS = 2 * I_FI + 2 * I_FO + I_WI + I_WO + 2 * I_L64 + I_L128;
    for (int it = gw; it < NITEMS; it += NGW) {
        int r = it;
        if (r < 2 * I_FI) { const bool second = r >= I_FI; if (second) r -= I_FI; const int nblk = 2 * DFF / 32, kb = r / nblk, nb = r % nblk, n0 = 32 * nb;
            const int j = n0 < DFF ? n0 : n0 - DFF, drow = 256 * (j / 128) + (n0 < DFF ? 0 : 128) + (j % 128);
            p0_transpose_item(second ? F.ff2_in : F.ff1_in, DM, 2 * DFF, second ? ((bf16*)(F.ws + WS_FF2IN)) : ((bf16*)(F.ws + WS_FF1IN)), drow, scr, 64 * kb, n0, F.lane); continue; }
        r -= 2 * I_FI;
        if (r < 2 * I_FO) { const bool second = r >= I_FO; if (second) r -= I_FO; const int nblk = DM / 32, kb = r / nblk, nb = r % nblk;
            p0_transpose_item(second ? F.ff2_out : F.ff1_out, DFF, DM, second ? ((bf16*)(F.ws + WS_FF2OUT)) : ((bf16*)(F.ws + WS_FF1OUT)), 32 * nb, scr, 64 * kb, 32 * nb, F.lane); continue; }
        r -= 2 * I_FO;
        if (r < I_WI) { const int nblk = PCOLS / 32, kb = r / nblk, nb = r % nblk; p0_transpose_item(F.w_in, DM, PCOLS, ((bf16*)(F.ws + WS_WIN)), 32 * nb, scr, 64 * kb, 32 * nb, F.lane); continue; }
        r -= I_WI;
        if (r < I_WO) { const int nblk = DM / 32, kb = r / nblk, nb = r % nblk; p0_transpose_item(F.w_out, DM, DM, ((bf16*)(F.ws + WS_WOUT)), 32 * nb, scr, 64 * kb, 32 * nb, F.lane); continue; }
        r -= I_WO;
        if (r < I_L64) { p0_transpose_item(F.w2, 64, RW, ((bf16*)(F.ws + WS_LORA)), 32 * r, scr, 0, 32 * r, F.lane); continue; }
        r -= I_L64;
        if (r < I_L64) { p0_transpose_item(F.a2, 64, RW, ((bf16*)(F.ws + WS_LORA) + 512 * 64), 32 * r, scr, 0, 32 * r, F.lane); continue; }
        r -= I_L64;
        { const int kb = r / 16, nb = r % 16; p0_transpose_item(F.g2, 128, RW, ((bf16*)(F.ws + WS_LORA) + 2 * 512 * 64), 32 * nb, scr, 64 * kb, 32 * nb, F.lane); }
    }
    const GAS f32x4* gp = (const GAS f32x4*)(F.gains) + F.lane;
    for (int m = gw; m < M; m += NGW) {
        const GAS f32x4* xr = (const GAS f32x4*)xrow_ptr(F, m) + F.lane;
        f32x4 v[4]; float s = 0.f;
#pragma unroll
        for (int j = 0; j < 4; ++j) { v[j] = xr[64 * j]; s += (v[j].x * v[j].x + v[j].y * v[j].y) + (v[j].z * v[j].z + v[j].w * v[j].w); }
        const float rstd = 1.0f / sqrtf(wave_sum(s) * (1.f / DM) + NORM_EPS);
        GAS unsigned long long* o8 = (GAS unsigned long long*)(((bf16*)(F.ws + WS_XN)) + (size_t)m * DM) + F.lane;
#pragma unroll
        for (int j = 0; j < 4; ++j) { const f32x4 g = gp[64 * j]; o8[64 * j] = (unsigned long long)pk2(v[j].x * rstd * g.x, v[j].y * rstd * g.y) | ((unsigned long long)pk2(v[j].z * rstd * g.z, v[j].w * rstd * g.w) << 32); }
    }
}
template <bool HAS_XN, int NSPLIT> __device__ __forceinline__ void rowwise_phase(Frame& F, const float* base_p, const float* base_s, float* outp, const float* ga, float scale, const float* gb) {
    const int gw = F.vcu * NWAVES + F.wave, NGW = F.G * NWAVES;
    const GAS f32x4* gap = (const GAS f32x4*)ga + F.lane; const GAS f32x4* gbp = (const GAS f32x4*)gb + F.lane;
    for (int m = gw; m < M; m += NGW) {
        const GAS f32x4* br = (const GAS f32x4*)(m < MP ? base_p + (size_t)m * DM : base_s + (size_t)(m - MP) * DM) + F.lane;
        f32x4 f[4], bsv[4]; float s = 0.f;
        if (m < MP) { const GAS f32x4* fr = (const GAS f32x4*)(((float*)(F.ws + WS_F)) + (size_t)m * DM) + F.lane;
#pragma unroll
            for (int j = 0; j < 4; ++j) f[j] = fr[64 * j]; }
        else {
            const GAS f32x4* fr = (const GAS f32x4*)(((float*)(F.ws + WS_SLAB)) + (size_t)(m - MP) * DM) + F.lane;
#pragma unroll
            for (int j = 0; j < 4; ++j) f[j] = fr[64 * j];
#pragma unroll
            for (int ks = 1; ks < NSPLIT; ++ks) { const GAS f32x4* fk = fr + (size_t)ks * MS * DM / 4;
#pragma unroll
                for (int j = 0; j < 4; ++j) f[j] += fk[64 * j]; }
        }
#pragma unroll
        for (int j = 0; j < 4; ++j) { bsv[j] = br[64 * j]; s += (f[j].x * f[j].x + f[j].y * f[j].y) + (f[j].z * f[j].z + f[j].w * f[j].w); }
        const float rstd = scale / sqrtf(wave_sum(s) * (1.f / DM) + NORM_EPS);
        GAS f32x4* orow = (GAS f32x4*)(outp + (size_t)m * DM) + F.lane; float s2 = 0.f;
#pragma unroll
        for (int j = 0; j < 4; ++j) { const f32x4 g = gap[64 * j]; f32x4 o = bsv[j] + f[j] * rstd * g; orow[64 * j] = o; f[j] = o; s2 += (o.x * o.x + o.y * o.y) + (o.z * o.z + o.w * o.w); }
        if (HAS_XN) {
            const float r2 = 1.0f / sqrtf(wave_sum(s2) * (1.f / DM) + NORM_EPS);
            GAS unsigned long long* o8 = (GAS unsigned long long*)(((bf16*)(F.ws + WS_XN)) + (size_t)m * DM) + F.lane;
#pragma unroll
            for (int j = 0; j < 4; ++j) { const f32x4 g = gbp[64 * j]; o8[64 * j] = (unsigned long long)pk2(f[j].x * r2 * g.x, f[j].y * r2 * g.y) | ((unsigned long long)pk2(f[j].z * r2 * g.z, f[j].w * r2 * g.w) << 32); }
        }
    }
}
__device__ __forceinline__ f32x4 lerp4(const float* cur, const float* prev, const float* mu, int c) {
    const f32x4 a = *(const GAS f32x4*)(cur + c), b = *(const GAS f32x4*)(prev + c), m = *(const GAS f32x4*)(mu + c); return a + (b - a) * m; }
__device__ __forceinline__ void prep_phase(Frame& F) {
    const int lane = F.lane, fr = lane & 15, fq = lane >> 4, h = F.wave;
    const float* PRb = (const float*)(F.ws + WS_PR);
    for (int tile = F.vcu; tile < M / 16; tile += F.G) {
        const int m = tile * 16 + fr; int t, b; const float* prevp; size_t sioff;
        if (m < MP) { t = m & (SEQ - 1); b = m >> 11; prevp = t ? PRb + (size_t)(m - 1) * RCOLS : (const float*)(F.ws + WS_ZERO); sioff = ((size_t)(b * RH + h) * SEQ + t) * 384; }
        else { const int ms = m - MP; t = ms & 3; b = ms >> 2; prevp = t ? PRb + (size_t)(m - 1) * RCOLS : F.state_shift + (size_t)b * RCOLS; sioff = SI_S0 + ((size_t)(b * RH + h) * DECS + t) * 384; }
        const float* curp = PRb + (size_t)m * RCOLS;
        bf16x8 xw[2], xa[2], xg[4];
#pragma unroll
        for (int s = 0; s < 2; ++s) { const int c = 1536 + 32 * s + 8 * fq; const f32x4 v0 = lerp4(curp, prevp, F.mu, c), v1 = lerp4(curp, prevp, F.mu, c + 4);
            float e[8] = {tanh_f(v0[0]), tanh_f(v0[1]), tanh_f(v0[2]), tanh_f(v0[3]), tanh_f(v1[0]), tanh_f(v1[1]), tanh_f(v1[2]), tanh_f(v1[3])}; xw[s] = pack8(e); }
        asm volatile("" ::: "memory");
#pragma unroll
        for (int s = 0; s < 2; ++s) { const int c = 1600 + 32 * s + 8 * fq; const f32x4 v0 = lerp4(curp, prevp, F.mu, c), v1 = lerp4(curp, prevp, F.mu, c + 4);
            float e[8] = {v0[0], v0[1], v0[2], v0[3], v1[0], v1[1], v1[2], v1[3]}; xa[s] = pack8(e); }
        asm volatile("" ::: "memory");
#pragma unroll
        for (int s = 0; s < 4; ++s) { const int c = 1664 + 32 * s + 8 * fq; const f32x4 v0 = lerp4(curp, prevp, F.mu, c), v1 = lerp4(curp, prevp, F.mu, c + 4);
            float e[8] = {sigm(v0[0]), sigm(v0[1]), sigm(v0[2]), sigm(v0[3]), sigm(v1[0]), sigm(v1[1]), sigm(v1[2]), sigm(v1[3])}; xg[s] = pack8(e);
            if (s == 1) asm volatile("" ::: "memory"); }
        asm volatile("" ::: "memory");
        float ssq = 0.f;
#pragma unroll
        for (int nb = 0; nb < 4; ++nb) { const int c = 64 * h + 16 * nb + 4 * fq; const f32x4 k4 = lerp4(curp, prevp, F.mu, 512 + c), kkp = *(const GAS f32x4*)(F.kkp + c); const f32x4 kk = k4 * kkp;
            ssq += (kk[0] * kk[0] + kk[1] * kk[1]) + (kk[2] * kk[2] + kk[3] * kk[3]); }
        ssq = xsum32(xsum16(ssq));
        const float rn = 1.0f / fmaxf(sqrtf(ssq), 1e-12f); float bon = 0.f;
        float* sip = (float*)(F.ws + WS_SI) + sioff;
        asm volatile("" ::: "memory");
#pragma unroll 1
        for (int nb = 0; nb < 4; ++nb) {
            const int cl = 16 * nb + 4 * fq, c = 64 * h + cl;
            f32x4 aw = {0.f, 0.f, 0.f, 0.f}, aa = aw, ag = aw;
            const bf16* wrow = (const bf16*)(F.ws + WS_LORA) + (size_t)(64 * h + 16 * nb + fr) * 64 + 8 * fq; const bf16* arow = wrow + 512 * 64; const bf16* grow = (const bf16*)(F.ws + WS_LORA) + 2 * 512 * 64 + (size_t)(64 * h + 16 * nb + fr) * 128 + 8 * fq;
#pragma unroll
            for (int s = 0; s < 2; ++s) { aw = __builtin_amdgcn_mfma_f32_16x16x32_bf16(*(const GAS bf16x8*)(wrow + 32 * s), xw[s], aw, 0, 0, 0); aa = __builtin_amdgcn_mfma_f32_16x16x32_bf16(*(const GAS bf16x8*)(arow + 32 * s), xa[s], aa, 0, 0, 0); }
#pragma unroll
            for (int s = 0; s < 4; ++s) ag = __builtin_amdgcn_mfma_f32_16x16x32_bf16(*(const GAS bf16x8*)(grow + 32 * s), xg[s], ag, 0, 0, 0);
            const f32x4 r4 = lerp4(curp, prevp, F.mu, c), k4 = lerp4(curp, prevp, F.mu, 512 + c), v4 = lerp4(curp, prevp, F.mu, 1024 + c);
            const f32x4 w0 = *(const GAS f32x4*)(F.w0 + c), a0 = *(const GAS f32x4*)(F.a0 + c), kkp = *(const GAS f32x4*)(F.kkp + c), ka = *(const GAS f32x4*)(F.ka + c), rk = *(const GAS f32x4*)(F.rk + c);
            f32x4 dec, a4;
#pragma unroll
            for (int i = 0; i < 4; ++i) { const float z = -(w0[i] + aw[i]);
                const float sp = fmaxf(z, 0.f) + __logf(1.f + __expf(-fabsf(z))); const float lw = -sp - 0.5f; dec[i] = __expf(-__expf(lw)); a4[i] = sigm(a0[i] + aa[i]); }
            const f32x4 kkn = (k4 * kkp) * rn; const f32x4 krp = k4 * (1.f + (a4 - 1.f) * ka); const f32x4 bb = kkn * a4; const f32x4 pr = r4 * krp * rk;
            bon += (pr[0] + pr[1]) + (pr[2] + pr[3]);
            *(GAS f32x4*)(sip + cl) = -kkn; *(GAS f32x4*)(sip + 64 + cl) = dec; *(GAS f32x4*)(sip + 128 + cl) = bb; *(GAS f32x4*)(sip + 192 + cl) = krp; *(GAS f32x4*)(sip + 256 + cl) = r4; *(GAS f32x4*)(sip + 320 + cl) = v4;
            *(GAS f32x4*)((float*)(F.ws + WS_G) + (size_t)m * 512 + c) = ag;
        }
        bon = xsum32(xsum16(bon));
        if (fq == 0) ((float*)(F.ws + WS_BONUS))[(size_t)m * RH + h] = bon;
    }
}
__device__ __forceinline__ void scan_sample_task(Frame& F, int cs) {
    const int kp = F.lane & 31, hr = F.lane >> 5, bh = cs >> 2;
    const float* src = (const float*)(F.ws + WS_SI) + SI_S0 + (size_t)bh * DECS * 384;
    f32x2 n2[DECS], w2[DECS], b2[DECS], k2[DECS], r2[DECS];
#pragma unroll
    for (int t = 0; t < DECS; ++t) { const float* sp = src + t * 384 + 2 * kp; n2[t] = *(const GAS f32x2*)(sp); w2[t] = *(const GAS f32x2*)(sp + 64); b2[t] = *(const GAS f32x2*)(sp + 128); k2[t] = *(const GAS f32x2*)(sp + 192); r2[t] = *(const GAS f32x2*)(sp + 256); }
#pragma unroll 2
    for (int i = 0; i < 8; ++i) {
        const int vrow = 2 * ((cs & 3) * 8 + i) + hr;
        f32x2 st = *(const GAS f32x2*)(F.state_wkv + ((size_t)bh * 64 + vrow) * 64 + 2 * kp); float vv[DECS];
#pragma unroll
        for (int t = 0; t < DECS; ++t) vv[t] = src[t * 384 + 320 + vrow];
#pragma unroll
        for (int t = 0; t < DECS; ++t) {
            const float sa = red32(st.x * n2[t].x + st.y * n2[t].y);
            st.x = st.x * w2[t].x + sa * b2[t].x + vv[t] * k2[t].x; st.y = st.y * w2[t].y + sa * b2[t].y + vv[t] * k2[t].y;
            const float y = red32(st.x * r2[t].x + st.y * r2[t].y);
            if (kp == 0) ((float*)(F.ws + WS_Y))[(size_t)(MP + (bh >> 3) * DECS + t) * 512 + (bh & 7) * 64 + vrow] = y;
        }
        *(GAS f32x2*)(F.out + OUT_WS + ((size_t)bh * 64 + vrow) * 64 + 2 * kp) = st;
    }
}
template <int CTRL> __device__ __forceinline__ float xr_stage(float lo, float hi, bool bit) { const float keep = bit ? hi : lo, send = bit ? lo : hi; return keep + dpp_mov<CTRL>(send); }
__device__ __forceinline__ void transpose_reduce16(const float (&P)[32], int lane, float& ylo, float& yhi) {
    float Q[16], R[8], T[4];
    const bool b3 = (lane & 8) != 0, b2 = (lane & 4) != 0, b1 = (lane & 2) != 0, b0 = (lane & 1) != 0;
#pragma unroll
    for (int i = 0; i < 8; ++i) { Q[i] = xr_stage<0x128>(P[i], P[i + 8], b3); Q[8 + i] = xr_stage<0x128>(P[16 + i], P[24 + i], b3); }
#pragma unroll
    for (int i = 0; i < 4; ++i) { R[i] = xr_stage<0x141>(Q[i], Q[i + 4], b2); R[4 + i] = xr_stage<0x141>(Q[8 + i], Q[12 + i], b2); }
#pragma unroll
    for (int i = 0; i < 2; ++i) { T[i] = xr_stage<0x4E>(R[i], R[i + 2], b1); T[2 + i] = xr_stage<0x4E>(R[4 + i], R[6 + i], b1); }
    ylo = xr_stage<0xB1>(T[0], T[1], b0); yhi = xr_stage<0xB1>(T[2], T[3], b0);
}
__device__ __forceinline__ void scan_prompt(Frame& F) {
    constexpr int TC = 32, CH = TC * 384, NCH = SEQ / TC, PF = 3;
    LAS float* buf = (LAS float*)(F.lds + RING_OFF);
    const int lane = F.lane, kq = lane & 15, ri = lane >> 4;
    volatile LAS unsigned* sctr = F.MISC + 16; unsigned epoch = *sctr >> 2;
    for (int item = F.vcu; item < NB * RH * 4; item += F.G) {
        const int bh = item >> 2, rg = item & 3, vrow = rg * 16 + (F.wave & 3) * 4 + ri;
        const float* src = (const float*)(F.ws + WS_SI) + (size_t)bh * SEQ * 384;
        float* yout = (float*)(F.ws + WS_Y) + (size_t)((bh >> 3) * SEQ + kq) * 512 + (bh & 7) * 64 + vrow;
        float s0 = 0.f, s1 = 0.f, s2 = 0.f, s3 = 0.f;
#define SCAN_STAGE(cc, bb) do { _Pragma("unroll") for (int _p = 0; _p < 12; ++_p) { const int pc = F.wave + 4 * _p; \
            __builtin_amdgcn_global_load_lds((const unsigned*)(src + (size_t)(cc) * CH + pc * 256 + lane * 4), (LAS unsigned*)(buf + (bb) * CH + pc * 256), 16, 0, 0); } } while (0)
#define SCAN_SYNC(WAITS) do { asm volatile(WAITS ::: "memory"); ++epoch; if (lane == 0) __hip_atomic_fetch_add((LAS unsigned*)sctr, 1u, __ATOMIC_RELAXED, __HIP_MEMORY_SCOPE_WORKGROUP); \
            while (*sctr < 4u * epoch) __builtin_amdgcn_s_sleep(1); asm volatile("" ::: "memory"); } while (0)
        SCAN_STAGE(0, 0);
        SCAN_SYNC("s_waitcnt vmcnt(0) lgkmcnt(0)");
        for (int c = 0; c < NCH; ++c) {
            const int cur = c & 1;
            if (c + 1 < NCH) SCAN_STAGE(c + 1, cur ^ 1);
            {
            const LAS float* bp = buf + cur * CH;
            f32x4 nn[TC], ww[TC], bb[TC], kk[TC], rr[TC]; float vv[TC], P[TC];
#define SCAN_LD(t) do { const LAS float* np = bp + (t) * 384 + 4 * kq; nn[t] = *(const LAS f32x4*)(np); ww[t] = *(const LAS f32x4*)(np + 64); bb[t] = *(const LAS f32x4*)(np + 128); kk[t] = *(const LAS f32x4*)(np + 192); \
                rr[t] = *(const LAS f32x4*)(np + 256); vv[t] = bp[(t) * 384 + 320 + vrow]; } while (0)
#define SCAN_STEP(t, RP, YP) do { float p_, a0_, a1_, a2_, a3_; \
                asm volatile("v_mul_f32 %[p], %[s0], %[n0]\n\tv_mul_f32 %[a0], %[s0], %[w0]\n\tv_fma_f32 %[p], %[s1], %[n1], %[p]\n\tv_mul_f32 %[a1], %[s1], %[w1]\n\tv_fma_f32 %[p], %[s2], %[n2], %[p]\n\tv_mul_f32 %[a2], %[s2], %[w2]\n\t" \
                    "v_fma_f32 %[p], %[s3], %[n3], %[p]\n\tv_mul_f32 %[a3], %[s3], %[w3]\n\tv_fma_f32 %[a0], %[vv], %[k0], %[a0]\n\tv_fma_f32 %[a1], %[vv], %[k1], %[a1]\n\t" \
                    "v_add_f32_dpp %[p], %[p], %[p] quad_perm:[1,0,3,2] row_mask:0xf bank_mask:0xf bound_ctrl:1\n\tv_fma_f32 %[a2], %[vv], %[k2], %[a2]\n\tv_fma_f32 %[a3], %[vv], %[k3], %[a3]\n\t" \
                    "v_add_f32_dpp %[p], %[p], %[p] quad_perm:[2,3,0,1] row_mask:0xf bank_mask:0xf bound_ctrl:1\n\tv_mul_f32 %[y], %[s0], %[r0]\n\tv_fma_f32 %[y], %[s1], %[r1], %[y]\n\t" \
                    "v_add_f32_dpp %[p], %[p], %[p] row_half_mirror row_mask:0xf bank_mask:0xf bound_ctrl:1\n\tv_fma_f32 %[y], %[s2], %[r2], %[y]\n\tv_fma_f32 %[y], %[s3], %[r3], %[y]\n\t" \
                    "v_add_f32_dpp %[p], %[p], %[p] row_mirror row_mask:0xf bank_mask:0xf bound_ctrl:1\n\ts_nop 0\n\t" \
                    "v_fma_f32 %[s0], %[p], %[b0], %[a0]\n\tv_fma_f32 %[s1], %[p], %[b1], %[a1]\n\tv_fma_f32 %[s2], %[p], %[b2], %[a2]\n\tv_fma_f32 %[s3], %[p], %[b3], %[a3]" \
                    : [s0] "+v"(s0), [s1] "+v"(s1), [s2] "+v"(s2), [s3] "+v"(s3), [y] "=&v"(YP), [p] "=&v"(p_), [a0] "=&v"(a0_), [a1] "=&v"(a1_), [a2] "=&v"(a2_), [a3] "=&v"(a3_) \
                    : [n0] "v"(nn[t][0]), [n1] "v"(nn[t][1]), [n2] "v"(nn[t][2]), [n3] "v"(nn[t][3]), [w0] "v"(ww[t][0]), [w1] "v"(ww[t][1]), [w2] "v"(ww[t][2]), [w3] "v"(ww[t][3]), \
                      [b0] "v"(bb[t][0]), [b1] "v"(bb[t][1]), [b2] "v"(bb[t][2]), [b3] "v"(bb[t][3]), [k0] "v"(kk[t][0]), [k1] "v"(kk[t][1]), [k2] "v"(kk[t][2]), [k3] "v"(kk[t][3]), [vv] "v"(vv[t]), \
                      [r0] "v"(RP[0]), [r1] "v"(RP[1]), [r2] "v"(RP[2]), [r3] "v"(RP[3])); } while (0)
#pragma unroll
            for (int t = 0; t < PF; ++t) SCAN_LD(t);
#pragma unroll
            for (int t = 0; t < TC; ++t) {
                if (t + PF < TC) SCAN_LD(t + PF);
                __builtin_amdgcn_sched_barrier(0);
                if (t == 0) { float dummy; SCAN_STEP(0, rr[0], dummy); (void)dummy; }
                else SCAN_STEP(t, rr[t - 1], P[t - 1]);
                __builtin_amdgcn_sched_barrier(0);
            }
            P[TC - 1] = (s0 * rr[TC - 1][0] + s1 * rr[TC - 1][1]) + (s2 * rr[TC - 1][2] + s3 * rr[TC - 1][3]);
#undef SCAN_STEP
#undef SCAN_LD
            float ylo, yhi; transpose_reduce16(P, lane, ylo, yhi);
            yout[(size_t)c * TC * 512] = ylo; yout[(size_t)(c * TC + 16) * 512] = yhi;
            }
            SCAN_SYNC("s_waitcnt vmcnt(2) lgkmcnt(0)");
        }
#undef SCAN_STAGE
#undef SCAN_SYNC
        *(GAS f32x4*)(F.out + OUT_WP + ((size_t)bh * 64 + vrow) * 64 + 4 * kq) = (f32x4){s0, s1, s2, s3};
    }
}
__device__ __forceinline__ void decode_task(Frame& F, int unit, int w) {
    const int lane = F.lane, j = lane & 15, grp = lane >> 4;
    const LAS float* lutD = (const LAS float*)(F.lds + LUTD_OFF);
    const int tq = j & 3, mp = (j >> 2) & 1, b = unit >> 2, h = unit & 3;
    bf16x8 qf[4];
#pragma unroll
    for (int s = 0; s < 4; ++s) { v4u z = {0u, 0u, 0u, 0u};
        if (j < 8 && (s >> 1) == mp) z = *(const GAS v4u*)(((bf16*)(F.ws + WS_QKV)) + (size_t)(MP + DECS * b + tq) * 1536 + (h * 2 + mp) * 64 + 32 * (s & 1) + 8 * grp);
        qf[s] = __builtin_bit_cast(bf16x8, z); }
    float mrow = -1e30f, lsum = 0.f; f32x4 o[8];
#pragma unroll
    for (int i = 0; i < 8; ++i) o[i] = (f32x4){0.f, 0.f, 0.f, 0.f};
    const int* pt = F.page_table + b * NPG;
    for (int it = 0; it <= 8; ++it) {
        const bool tail = (it == 8);
        if (tail && w != 0) break;
        const int p0 = 256 * w + 32 * it;
        f32x4 sT[2]; const float* vbase; size_t vstride;
        if (!tail) {
            const int page = pt[p0 >> 7]; const size_t tok0 = (size_t)page * PAGE + (p0 & 127);
#pragma unroll
            for (int T = 0; T < 2; ++T) { const float* kp_ = F.cache_k + ((tok0 + 16 * T + j) * 4 + h) * 128 + 8 * grp; f32x4 acc = {0.f, 0.f, 0.f, 0.f};
#pragma unroll
                for (int s = 0; s < 4; ++s) { const f32x4 a0 = *(const GAS f32x4*)(kp_ + 32 * s), a1 = *(const GAS f32x4*)(kp_ + 32 * s + 4);
                    float e[8] = {a0[0], a0[1], a0[2], a0[3], a1[0], a1[1], a1[2], a1[3]}; acc = __builtin_amdgcn_mfma_f32_16x16x32_bf16(pack8(e), qf[s], acc, 0, 0, 0); }
                sT[T] = acc; }
            if (p0 >= SEQ - 128) {
#pragma unroll
                for (int T = 0; T < 2; ++T)
#pragma unroll
                    for (int r = 0; r < 4; ++r) { int n = (SEQ + tq) - (p0 + 16 * T + 4 * grp + r); n = n > 127 ? 127 : n; sT[T][r] += lutD[h * 128 + n]; } }
            vbase = F.cache_v + (tok0 * 4 + h) * 128; vstride = 512;
        } else {
            const float* kp_ = F.out + OUT_KS + ((size_t)(DECS * b + (j & 3)) * 512) + h * 128 + 8 * grp; f32x4 acc = {0.f, 0.f, 0.f, 0.f};
#pragma unroll
            for (int s = 0; s < 4; ++s) { f32x4 a0 = {0.f, 0.f, 0.f, 0.f}, a1 = a0; if (j < 4) { a0 = *(const GAS f32x4*)(kp_ + 32 * s); a1 = *(const GAS f32x4*)(kp_ + 32 * s + 4); }
                float e[8] = {a0[0], a0[1], a0[2], a0[3], a1[0], a1[1], a1[2], a1[3]}; acc = __builtin_amdgcn_mfma_f32_16x16x32_bf16(pack8(e), qf[s], acc, 0, 0, 0); }
#pragma unroll
            for (int r = 0; r < 4; ++r) { const int key = 4 * grp + r; const bool ok = key < 4 && key <= tq; const int n = ok ? tq - key : 0; acc[r] = ok ? acc[r] + lutD[h * 128 + n] : -INFINITY; }
            sT[0] = acc; sT[1] = (f32x4){-INFINITY, -INFINITY, -INFINITY, -INFINITY};
            vbase = F.out + OUT_VS + (size_t)(DECS * b) * 512 + h * 128; vstride = 512;
        }
        float tmax = fmaxf(fmaxf(fmaxf(sT[0][0], sT[0][1]), fmaxf(sT[0][2], sT[0][3])), fmaxf(fmaxf(sT[1][0], sT[1][1]), fmaxf(sT[1][2], sT[1][3])));
        tmax = xmax32(xmax16(tmax));
        const float mnew = fmaxf(mrow, tmax), alpha = __builtin_amdgcn_exp2f(mrow - mnew); mrow = mnew;
        float p[8]; float ps = 0.f;
#pragma unroll
        for (int r = 0; r < 4; ++r) { p[r] = __builtin_amdgcn_exp2f(sT[0][r] - mnew); p[4 + r] = __builtin_amdgcn_exp2f(sT[1][r] - mnew); ps += p[r] + p[4 + r]; }
        lsum = lsum * alpha + ps;
        const bf16x8 pf = pack8(p);
#pragma unroll
        for (int blk = 0; blk < 8; ++blk) { float v8[8];
#pragma unroll
            for (int e = 0; e < 8; ++e) { const int key = (e < 4) ? 4 * grp + e : 16 + 4 * grp + (e - 4);
                if (!tail) v8[e] = vbase[(size_t)key * vstride + 16 * blk + j];
                else v8[e] = (key < 4) ? vbase[(size_t)key * vstride + 16 * blk + j] : 0.f; }
            o[blk] = o[blk] * alpha; o[blk] = __builtin_amdgcn_mfma_f32_16x16x32_bf16(pack8(v8), pf, o[blk], 0, 0, 0); }
    }
    lsum = xsum32(xsum16(lsum));
    if (j < 8) {
        float* dpo = (float*)(F.ws + WS_DPO) + ((size_t)(unit * 8 + w) * 8 + j) * 128 + 4 * grp;
#pragma unroll
        for (int blk = 0; blk < 8; ++blk) *(GAS f32x4*)(dpo + 16 * blk) = o[blk];
        if (grp == 0) { float* dpm = (float*)(F.ws + WS_DPM) + (size_t)(unit * 8 + w) * 16; dpm[j] = mrow; dpm[8 + j] = lsum; }
    }
}
__device__ __forceinline__ void prompt_attn(Frame& F, char* ldsg, int reps) {
    attn_body::lds_cfptr lut = (attn_body::lds_cfptr)(F.lds + LUTR_OFF);
    for (int i = F.vcu; i < NB * 16 * 8 * reps; i += F.G) {
        const int jj = i & 255, k = (i >> 8) & 3, bvh = jj >> 1, s = 2 * (jj & 1) + (k >> 1), qb = (k & 1) ? 7 - s : s;
        const int b = bvh >> 4, vh = bvh & 15, h = vh >> 2, mp = (vh >> 1) & 1, half = vh & 1;
        const attn_body::bf16* Q = (const attn_body::bf16*)((bf16*)(F.ws + WS_QKV)) + (h * 2 + mp) * 64; const attn_body::bf16* K = (const attn_body::bf16*)((bf16*)(F.ws + WS_QKV)) + 512 + (h * 2 + mp) * 64;
        const attn_body::bf16* V = (const attn_body::bf16*)((bf16*)(F.ws + WS_QKV)) + 1024 + h * 128 + half * 64; attn_body::bf16* O = (attn_body::bf16*)((bf16*)(F.ws + WS_O)) + vh * 64;
        attn_body::attn_unit<8>(b, qb, Q, K, V, O, lut + h * 640, ldsg + RING_OFF);
    }
}
__device__ __forceinline__ void post_phase(Frame& F, float lam) {
    const int gw = F.vcu * NWAVES + F.wave, NGW = F.G * NWAVES, lane = F.lane, c0 = 8 * lane, hh = lane >> 3;
    f32x4 gnw[2], gnb[2];
    gnw[0] = *(const GAS f32x4*)(F.gn_w + c0); gnw[1] = *(const GAS f32x4*)(F.gn_w + c0 + 4); gnb[0] = *(const GAS f32x4*)(F.gn_b + c0); gnb[1] = *(const GAS f32x4*)(F.gn_b + c0 + 4);
    const int ah = lane >> 4, ahalf = (lane >> 3) & 1, ad = 8 * (lane & 7);
    f32x4 sl[2]; sl[0] = *(const GAS f32x4*)(F.subln + (c0 & 127)); sl[1] = *(const GAS f32x4*)(F.subln + (c0 & 127) + 4);
    for (int m = gw; m < M; m += NGW) {
        size_t sioff;
        if (m < MP) sioff = ((size_t)((m >> 11) * RH + hh) * SEQ + (m & (SEQ - 1))) * 384; else { const int ms = m - MP; sioff = SI_S0 + ((size_t)((ms >> 2) * RH + hh) * DECS + (ms & 3)) * 384; }
        const float* yp = ((float*)(F.ws + WS_Y)) + (size_t)m * 512 + c0; const float* vp = ((float*)(F.ws + WS_SI)) + sioff + 5 * 64 + (c0 & 63); const float* gp = ((float*)(F.ws + WS_G)) + (size_t)m * 512 + c0;
        f32x4 y[2], vr[2], g[2]; y[0] = *(const GAS f32x4*)yp; y[1] = *(const GAS f32x4*)(yp + 4); vr[0] = *(const GAS f32x4*)vp; vr[1] = *(const GAS f32x4*)(vp + 4); g[0] = *(const GAS f32x4*)gp; g[1] = *(const GAS f32x4*)(gp + 4);
        const float bon = ((float*)(F.ws + WS_BONUS))[(size_t)m * RH + hh];
        const float mean = red8((y[0][0] + y[0][1]) + (y[0][2] + y[0][3]) + (y[1][0] + y[1][1]) + (y[1][2] + y[1][3])) * (1.f / 64.f);
        const f32x4 d0 = y[0] - mean, d1 = y[1] - mean;
        const float var = red8((d0[0] * d0[0] + d0[1] * d0[1]) + (d0[2] * d0[2] + d0[3] * d0[3]) + (d1[0] * d1[0] + d1[1] * d1[1]) + (d1[2] * d1[2] + d1[3] * d1[3])) * (1.f / 64.f);
        const float rstd = 1.0f / sqrtf(var + GN_EPS);
        const f32x4 o0 = (d0 * rstd * gnw[0] + gnb[0] + vr[0] * bon) * g[0], o1 = (d1 * rstd * gnw[1] + gnb[1] + vr[1] * bon) * g[1];
        v4u w; w.x = pk2(o0[0], o0[1]); w.y = pk2(o0[2], o0[3]); w.z = pk2(o1[0], o1[1]); w.w = pk2(o1[2], o1[3]);
        *(GAS v4u*)(((bf16*)(F.ws + WS_XM)) + (size_t)m * DM + c0) = w;
        if (m >= MP) {
            const int ms = m - MP, bq = ms >> 2, t4 = ms & 3, unit = bq * 4 + ah, dv0 = 8 * (lane & 15); float res[2][8];
#pragma unroll
            for (int q = 0; q < 2; ++q) { const int row = 4 * q + t4; const float* dpm = (const float*)(F.ws + WS_DPM) + (size_t)unit * 128; float ms_[8], mx = -1e30f;
#pragma unroll
                for (int s = 0; s < 8; ++s) { ms_[s] = dpm[s * 16 + row]; mx = fmaxf(mx, ms_[s]); }
                float L = 0.f; f32x4 a0 = {0.f, 0.f, 0.f, 0.f}, a1 = a0;
#pragma unroll
                for (int s = 0; s < 8; ++s) { const float sc = __builtin_amdgcn_exp2f(ms_[s] - mx); L += dpm[s * 16 + 8 + row] * sc; const float* po = (const float*)(F.ws + WS_DPO) + ((size_t)(unit * 8 + s) * 8 + row) * 128 + dv0;
                    a0 += *(const GAS f32x4*)po * sc; a1 += *(const GAS f32x4*)(po + 4) * sc; }
                const float il = 1.0f / L;
#pragma unroll
                for (int i = 0; i < 4; ++i) { res[q][i] = a0[i] * il; res[q][4 + i] = a1[i] * il; } }
            float d[8], ss = 0.f;
#pragma unroll
            for (int i = 0; i < 8; ++i) { d[i] = res[0][i] - lam * res[1][i]; ss += d[i] * d[i]; }
            const float rs = (1.f - LAM_INIT) / sqrtf(red16(ss) * (1.f / 128.f) + SUBLN_EPS);
            v4u q; q.x = pk2(d[0] * rs * sl[0][0], d[1] * rs * sl[0][1]); q.y = pk2(d[2] * rs * sl[0][2], d[3] * rs * sl[0][3]); q.z = pk2(d[4] * rs * sl[1][0], d[5] * rs * sl[1][1]); q.w = pk2(d[6] * rs * sl[1][2], d[7] * rs * sl[1][3]);
            *(GAS v4u*)(((bf16*)(F.ws + WS_XM)) + (size_t)m * DM + 512 + c0) = q;
        } else {
            const v4u a = *(const GAS v4u*)(((bf16*)(F.ws + WS_O)) + (size_t)m * 1024 + 64 * (4 * ah + ahalf) + ad), bq = *(const GAS v4u*)(((bf16*)(F.ws + WS_O)) + (size_t)m * 1024 + 64 * (4 * ah + 2 + ahalf) + ad);
            float d[8]; const unsigned aa[4] = {a.x, a.y, a.z, a.w}, bb[4] = {bq.x, bq.y, bq.z, bq.w}; float ss = 0.f;
#pragma unroll
            for (int i = 0; i < 4; ++i) { const float a_lo = __uint_as_float(aa[i] << 16), a_hi = __uint_as_float(aa[i] & 0xffff0000u), b_lo = __uint_as_float(bb[i] << 16), b_hi = __uint_as_float(bb[i] & 0xffff0000u);
                d[2 * i] = a_lo - lam * b_lo; d[2 * i + 1] = a_hi - lam * b_hi; ss += d[2 * i] * d[2 * i] + d[2 * i + 1] * d[2 * i + 1]; }
            const float rs = (1.f - LAM_INIT) / sqrtf(red16(ss) * (1.f / 128.f) + SUBLN_EPS);
            v4u q; q.x = pk2(d[0] * rs * sl[0][0], d[1] * rs * sl[0][1]); q.y = pk2(d[2] * rs * sl[0][2], d[3] * rs * sl[0][3]); q.z = pk2(d[4] * rs * sl[1][0], d[5] * rs * sl[1][1]); q.w = pk2(d[6] * rs * sl[1][2], d[7] * rs * sl[1][3]);
            *(GAS v4u*)(((bf16*)(F.ws + WS_XM)) + (size_t)m * DM + 512 + c0) = q;
        }
    }
}
struct Args { const void* in[31]; float* out; unsigned char* ws; int ph_lo, ph_hi; };
__global__ void __launch_bounds__(NWAVES * 64, 2) mk_fwd(Args args) {
    extern __shared__ __attribute__((aligned(16))) unsigned char lds[];
    Frame F;
    F.lds = (LAS unsigned char*)lds; F.MISC = (volatile LAS unsigned*)(F.lds + MISC_OFF);
    F.tid = threadIdx.x; F.lane = F.tid & 63; F.wave = __builtin_amdgcn_readfirstlane(F.tid >> 6);
    F.G = gridDim.x; { const int bx = blockIdx.x; F.vcu = (F.G % 8 == 0) ? (bx % 8) * (F.G / 8) + bx / 8 : bx; }
    unsigned char* ws = args.ws;
    F.ctl = (gu32*)(ws + WS_CTL);
    F.x_p = (const float*)args.in[0]; F.x_s = (const float*)args.in[1]; F.cache_k = (const float*)args.in[2]; F.cache_v = (const float*)args.in[3]; F.page_table = (const int*)args.in[4];
    F.state_wkv = (const float*)args.in[5]; F.state_shift = (const float*)args.in[6]; F.gains = (const float*)args.in[7]; F.ff1_in = (const float*)args.in[8]; F.ff1_out = (const float*)args.in[9];
    F.ff2_in = (const float*)args.in[10]; F.ff2_out = (const float*)args.in[11]; F.w_in = (const float*)args.in[12]; F.w_out = (const float*)args.in[13]; F.rel_tab = (const float*)args.in[14];
    F.lq1 = (const float*)args.in[15]; F.lk1 = (const float*)args.in[16]; F.lq2 = (const float*)args.in[17]; F.lk2 = (const float*)args.in[18]; F.subln = (const float*)args.in[19];
    F.mu = (const float*)args.in[20]; F.w0 = (const float*)args.in[21]; F.w2 = (const float*)args.in[22]; F.a0 = (const float*)args.in[23]; F.a2 = (const float*)args.in[24]; F.g2 = (const float*)args.in[25];
    F.kkp = (const float*)args.in[26]; F.ka = (const float*)args.in[27]; F.rk = (const float*)args.in[28]; F.gn_w = (const float*)args.in[29]; F.gn_b = (const float*)args.in[30];
    F.out = args.out;
    F.ws = ws;
    for (int u = F.tid; u < (MISC_OFF + 128 - LDSCTL_OFF) / 4; u += NWAVES * 64) ((LAS unsigned*)(F.lds + LDSCTL_OFF))[u] = 0u;
    __syncthreads();
    XcdBarrier bar; bar.bar = (unsigned*)(F.ctl + CW_BAR); bar.x = 0; bar.st = nullptr;
    if (!MK_PER_PHASE) bar = xcd_barrier_post((unsigned*)(F.ctl + CW_BAR), F.MISC + 8);
#define GRID_BAR() do { if (!MK_PER_PHASE) xcd_barrier(bar); } while (0)
    const int lo = args.ph_lo, hi = args.ph_hi;
#ifndef MK_PHASE_MASK
#define MK_PHASE_MASK 0x1fff
#endif
#define IN(k) (((MK_PHASE_MASK >> (k)) & 1) && lo <= (k) && (k) < hi)
#define BOTH(k) (IN(k) && IN((k) + 1))
#ifndef MK_DUP_PH
#define MK_DUP_PH 0
#endif
#define REPS(k) ((((MK_DUP_PH) >> (k)) & 1) ? 2 : 1)
    const float* g = F.gains;
    if (IN(0)) { for (int rep = 0; rep < REPS(0); ++rep) p0_prologue(F); if (BOTH(0)) GRID_BAR(); }
    if (IN(1)) { pg8::Gemm gm{((bf16*)(F.ws + WS_XN)), ((bf16*)(F.ws + WS_FF1IN)), M, 2 * DFF, DM}; pg8::StaticOrder S; S.init(M, 2 * DFF, F.G, (int)blockIdx.x, DM); pg8::EpiSwiGLU E{((bf16*)(F.ws + WS_H)), DFF};
        for (int rep = 0; rep < REPS(1); ++rep) pg8::gemm_phase<pg8::EpiSwiGLU, pg8::StaticOrder, true, true>(F.lds + RING_OFF, gm, S, E); if (BOTH(1)) GRID_BAR(); }
    if (IN(2)) { pg8::Gemm gm{((bf16*)(F.ws + WS_H)), ((bf16*)(F.ws + WS_FF1OUT)), M, DM, DFF}; pg8::TailSplitOrder S; S.init(MP, MS, DM, F.G, (int)blockIdx.x, DFF); pg8::EpiF32 E{((float*)(F.ws + WS_F)), DM, (float*)(F.ws + WS_SLAB), MP, MS, DFF / 64};
        for (int rep = 0; rep < REPS(2); ++rep) pg8::gemm_phase<pg8::EpiF32, pg8::TailSplitOrder, true, true>(F.lds + RING_OFF, gm, S, E); if (BOTH(2)) GRID_BAR(); }
    if (IN(3)) { for (int rep = 0; rep < REPS(3); ++rep) rowwise_phase<true, DFF / 256>(F, F.x_p, F.x_s, ((float*)(F.ws + WS_HRES)), g + 1 * DM, 0.5f, g + 2 * DM); if (BOTH(3)) GRID_BAR(); }
    if (IN(4)) { pg8::Gemm gm{((bf16*)(F.ws + WS_XN)), ((bf16*)(F.ws + WS_WIN)), M, PCOLS, DM}; pg8::StaticOrder S; S.init(M, PCOLS, F.G, (int)blockIdx.x, DM);
        pg8::EpiWin E{((bf16*)(F.ws + WS_QKV)), ((float*)(F.ws + WS_PR)), F.out + OUT_KP, F.out + OUT_VP, F.out + OUT_KS, F.out + OUT_VS, F.out + OUT_SP, F.out + OUT_SS, QSCALE, MP, SEQ};
        for (int rep = 0; rep < REPS(4); ++rep) pg8::gemm_phase<pg8::EpiWin, pg8::StaticOrder, true, true>(F.lds + RING_OFF, gm, S, E); if (BOTH(4)) GRID_BAR(); }
#ifndef MK_DUP_P5
#define MK_DUP_P5 0
#endif
    if (IN(5)) { prep_phase(F); if (MK_DUP_P5) prep_phase(F); if (BOTH(5)) GRID_BAR(); }
    if (IN(6)) {
        LAS float* lutR = (LAS float*)(F.lds + LUTR_OFF); LAS float* lutD = (LAS float*)(F.lds + LUTD_OFF);
        for (int i = F.tid; i < 4 * 640; i += NWAVES * 64) { const int h = i / 640, j = i % 640, n = 383 - j; lutR[i] = n < 0 ? -INFINITY : bias_delta(F.rel_tab, n, h); }
        for (int i = F.tid; i < 4 * 128; i += NWAVES * 64) lutD[i] = bias_delta(F.rel_tab, i & 127, i >> 7);
        __syncthreads();
#ifndef MK_DUP_P6
#define MK_DUP_P6 0
#endif
        volatile LAS unsigned* tctr = F.MISC + 24;
        for (int rep = 0; rep < ((MK_DUP_P6 & 2) ? 2 : 1); ++rep) { if (F.wave < 4) scan_prompt(F); }
        constexpr int DT = DECB * 4 * 8, ST = DECB * RH * 4;
        for (;;) {
            unsigned lt = 0; if (F.lane == 0) lt = __hip_atomic_fetch_add((LAS unsigned*)tctr, 1u, __ATOMIC_RELAXED, __HIP_MEMORY_SCOPE_WORKGROUP);
            lt = (unsigned)__builtin_amdgcn_readfirstlane((int)lt);
            const int per = (DT + F.G - 1) / F.G;
            if ((int)lt < per) { const int gt = F.vcu * per + (int)lt; if (gt < DT) decode_task(F, gt >> 3, gt & 7); continue; }
            const int ls = (int)lt - per, pers = (ST + F.G - 1) / F.G;
            if (ls < pers) { const int gs = F.vcu * pers + ls; if (gs < ST) scan_sample_task(F, gs); continue; }
            break;
        }
        __syncthreads();
        prompt_attn(F, (char*)lds, (MK_DUP_P6 & 4) ? 2 : 1);
        if (BOTH(6)) GRID_BAR(); }
    if (IN(7)) { const float lam = compute_lam(F); for (int rep = 0; rep < REPS(7); ++rep) post_phase(F, lam); if (BOTH(7)) GRID_BAR(); }
    if (IN(8)) { pg8::Gemm gm{((bf16*)(F.ws + WS_XM)), ((bf16*)(F.ws + WS_WOUT)), M, DM, DM}; pg8::TailSplitOrder S; S.init(MP, MS, DM, F.G, (int)blockIdx.x, DM); pg8::EpiF32 E{((float*)(F.ws + WS_F)), DM, (float*)(F.ws + WS_SLAB), MP, MS, DM / 64};
        for (int rep = 0; rep < REPS(8); ++rep) pg8::gemm_phase<pg8::EpiF32, pg8::TailSplitOrder, true, true>(F.lds + RING_OFF, gm, S, E); if (BOTH(8)) GRID_BAR(); }
    if (IN(9)) { rowwise_phase<true, DM / 256>(F, ((float*)(F.ws + WS_HRES)), ((float*)(F.ws + WS_HRES)) + (size_t)MP * DM, ((float*)(F.ws + WS_HRES)), g + 3 * DM, 1.0f, g + 4 * DM); if (BOTH(9)) GRID_BAR(); }
    if (IN(10)) { pg8::Gemm gm{((bf16*)(F.ws + WS_XN)), ((bf16*)(F.ws + WS_FF2IN)), M, 2 * DFF, DM}; pg8::StaticOrder S; S.init(M, 2 * DFF, F.G, (int)blockIdx.x, DM); pg8::EpiSwiGLU E{((bf16*)(F.ws + WS_H)), DFF};
        for (int rep = 0; rep < REPS(10); ++rep) pg8::gemm_phase<pg8::EpiSwiGLU, pg8::StaticOrder, true, true>(F.lds + RING_OFF, gm, S, E); if (BOTH(10)) GRID_BAR(); }
    if (IN(11)) { pg8::Gemm gm{((bf16*)(F.ws + WS_H)), ((bf16*)(F.ws + WS_FF2OUT)), M, DM, DFF}; pg8::TailSplitOrder S; S.init(MP, MS, DM, F.G, (int)blockIdx.x, DFF); pg8::EpiF32 E{((float*)(F.ws + WS_F)), DM, (float*)(F.ws + WS_SLAB), MP, MS, DFF / 64};
        for (int rep = 0; rep < REPS(11); ++rep) pg8::gemm_phase<pg8::EpiF32, pg8::TailSplitOrder, true, true>(F.lds + RING_OFF, gm, S, E); if (BOTH(11)) GRID_BAR(); }
    if (IN(12)) { for (int rep = 0; rep < REPS(12); ++rep) rowwise_phase<false, DFF / 256>(F, ((float*)(F.ws + WS_HRES)), ((float*)(F.ws + WS_HRES)) + (size_t)MP * DM, F.out + OUT_Y, g + 5 * DM, 0.5f, g + 5 * DM); }
#undef IN
#undef BOTH
#undef GRID_BAR
}

extern "C" void kernel_launch(void* const* d_in, const int* in_sizes, int n_in, void* d_out, int out_size, void* d_ws, size_t ws_size, hipStream_t stream) {
    static int grid = 0;
    if (grid == 0) {
        if (n_in != 31 || (size_t)out_size != OUT_END || ws_size < WS_END) { fprintf(stderr, "kernel_launch: unexpected shapes: n_in %d out %d ws %zu\n", n_in, out_size, ws_size); grid = -1; return; }
        int dev = 0, cus = 0, per_cu = 0;
        if (hipGetDevice(&dev) != hipSuccess || hipDeviceGetAttribute(&cus, hipDeviceAttributeMultiprocessorCount, dev) != hipSuccess) { grid = -1; return; }
        if (hipFuncSetAttribute((const void*)mk_fwd, hipFuncAttributeMaxDynamicSharedMemorySize, LDS_BYTES) != hipSuccess) { fprintf(stderr, "kernel_launch: hipFuncSetAttribute failed\n"); grid = -1; return; }
        if (hipOccupancyMaxActiveBlocksPerMultiprocessor(&per_cu, (const void*)mk_fwd, NWAVES * 64, LDS_BYTES) != hipSuccess || per_cu < 1) fprintf(stderr, "kernel_launch: occupancy query reports %d\n", per_cu);
        (void)hipGetLastError();
        grid = cus;
    }
    if (grid < 0) return;
    if (hipMemsetAsync((char*)d_ws + WS_CTL, 0, CTL_ZERO_BYTES, stream) != hipSuccess) return;
    Args a{};
    for (int i = 0; i < 31; ++i) a.in[i] = d_in[i];
    a.out = (float*)d_out; a.ws = (unsigned char*)d_ws;
#if MK_PER_PHASE
    for (int p = 0; p < NPHASE; ++p) { a.ph_lo = p; a.ph_hi = p + 1; hipLaunchKernelGGL(mk_fwd, dim3(grid), dim3(NWAVES * 64), LDS_BYTES, stream, a); }
#else
    a.ph_lo = 0; a.ph_hi = NPHASE; hipLaunchKernelGGL(mk_fwd, dim3(grid), dim3(NWAVES * 64), LDS_BYTES, stream, a);
#endif
}
```

```cpp
#include <hip/hip_runtime.h>
#include <cstdio>
#include <cstdint>
#ifndef MK_PER_PHASE
#define MK_PER_PHASE 0
#endif

#ifndef MK_SCAN_PROBE
#define MK_SCAN_PROBE 0
#endif
namespace pg8 {
#define PG8_LAS __attribute__((address_space(3)))
typedef unsigned short bf16_t;
typedef short bf16x8 __attribute__((ext_vector_type(8)));
typedef float f32x4 __attribute__((ext_vector_type(4)));
typedef unsigned u32x4 __attribute__((ext_vector_type(4)));
constexpr int BM = 256, BK = 64, HALF = 128, HTB = HALF * BK * 2  , STAGE_BYTES = 8 * HTB, NXCD = 8, WGM = 8;

__host__ __device__ __forceinline__ int lds_byte(int r, int c) { const int st = (r >> 4) * 2 + (c >> 5), rr = r & 15, cc = c & 31, ob = rr * 64 + cc * 2; return st * 1024 + (ob ^ (((ob >> 9) & 1) << 5)); }
__host__ __device__ __forceinline__ void stage_rc(int b, int& R, int& C) { const int st = b / 1024, sb = b % 1024, swz = sb ^ (((sb >> 9) & 1) << 5); R = (st >> 1) * 16 + swz / 64; C = (st & 1) * 32 + (swz % 64) / 2; }
__host__ __device__ __forceinline__ int perm32(int rho) { const int n = rho >> 4, i = rho & 15; return 8 * (i >> 2) + 4 * n + (i & 3); }

struct Unit { int pm, pn, kt0, nkt; };
struct Gemm { const bf16_t* A; const bf16_t* Bt; int M, N, K; };

struct StaticOrder {
    int nM, nN, nwg, G, c, nkt;
    __host__ __device__ void init(int M, int N, int G_, int c_, int K_) { nM = M / BM; nN = N / BM; nwg = nM * nN; G = G_; c = c_; nkt = K_ / BK; }
    __host__ __device__ bool next(int i, Unit& u) const {
        const long L = (long)i * G + c; if (L >= nwg) return false;
        int wgid = (int)L; { const int q = nwg / NXCD, r = nwg % NXCD, xcd = wgid % NXCD, off = wgid / NXCD; wgid = (xcd < r ? xcd * (q + 1) : r * (q + 1) + (xcd - r) * q) + off; }
        const int nig = WGM * nN, gid = wgid / nig, fm = gid * WGM, gsz = (nM - fm) < WGM ? (nM - fm) : WGM;
        u.pm = fm + ((wgid % nig) % gsz); u.pn = (wgid % nig) / gsz; u.kt0 = 0; u.nkt = nkt; return true;
    }
    __device__ __forceinline__ void a_ready(const Unit&) const {}
    __device__ __forceinline__ void done(const Unit&) const {}
};

constexpr int SPLIT_KT = 4;
struct TailSplitOrder {
    StaticOrder main; int nmain, nsplit, ntail, G, c, pm0, nN;
    __host__ __device__ void init(int Mmain, int Mtail, int N, int G_, int c_, int K_) { main.init(Mmain, N, G_, c_, K_); nmain = main.nwg; nN = N / BM; nsplit = (K_ / BK) / SPLIT_KT; ntail = (Mtail / BM) * nN * nsplit; G = G_; c = c_; pm0 = Mmain / BM; }
    __host__ __device__ bool next(int i, Unit& u) const {
        const long L = (long)i * G + c; if (L < nmain) return main.next(i, u);
        const int t = (int)(L - nmain); if (t >= ntail) return false;
        const int ks = t % nsplit, r = t / nsplit; u.pn = r % nN; u.pm = pm0 + r / nN; u.kt0 = ks * SPLIT_KT; u.nkt = SPLIT_KT; return true;
    }
    __device__ __forceinline__ void a_ready(const Unit&) const {}
    __device__ __forceinline__ void done(const Unit&) const {}
};

__device__ __forceinline__ unsigned cvt_pk_bf16(float lo, float hi) { unsigned r; asm volatile("v_cvt_pk_bf16_f32 %0, %1, %2" : "=v"(r) : "v"(lo), "v"(hi)); return r; }
typedef float f32x2 __attribute__((ext_vector_type(2)));
__device__ __forceinline__ f32x2 gelu_pk(f32x2 v) {
    const f32x2 av = __builtin_elementwise_abs(v), d = av * 0.2316418882f + 1.0f;
    f32x2 t; t.x = __builtin_amdgcn_rcpf(d.x); t.y = __builtin_amdgcn_rcpf(d.y);
    f32x2 q = t * 0.5307027145f + (-0.7265760135f); q = q * t + 0.7107068705f; q = q * t + (-0.142248368f); q = q * t + 0.127414796f; q = q * t;
    const f32x2 s = (v * v) * (-0.72134752044f);
    f32x2 e; e.x = __builtin_amdgcn_exp2f(s.x); e.y = __builtin_amdgcn_exp2f(s.y);
    const f32x2 m = v * (q * e), r = v - m;
    f32x2 o; o.x = v.x < 0.f ? m.x : r.x; o.y = v.y < 0.f ? m.y : r.y; return o;
}

template <int ACT  > struct EpiBf16 {
    static constexpr bool PERM = true, AFTER_DRAIN = false; static_assert(ACT == 0 || ACT == 1, "EpiBf16: ACT is 0 (none) or 1 (gelu_pk)");
    bf16_t* O; int ldc; const float* bias; int split_cols; size_t split_stride; float scale0;
    __device__ __forceinline__ void operator()(const f32x4 (&acc)[2][2][4][2], const Unit& u, int wr, int wc, int fr, int fq) const {
        const int row0 = u.pm * BM + wr * 64 + fr; int colt = u.pn * BM; bf16_t* base = O;
        float sc = 1.f; if (split_cols) { const int t = colt / split_cols; base += (size_t)t * split_stride; colt -= t * split_cols; if (t == 0) sc = scale0; }
        const int col0 = colt + wc * 32 + 8 * fq, bcol0 = u.pn * BM + wc * 32 + 8 * fq;
        f32x4 bv[2][2];
#pragma unroll
        for (int bj = 0; bj < 2; ++bj)
#pragma unroll
            for (int n = 0; n < 2; ++n) bv[bj][n] = bias ? *(const f32x4*)(bias + bcol0 + bj * HALF + 4 * n) : (f32x4){0.f, 0.f, 0.f, 0.f};
#pragma unroll
        for (int ai = 0; ai < 2; ++ai)
#pragma unroll
            for (int m = 0; m < 4; ++m) { bf16_t* rowp = base + (size_t)(row0 + ai * HALF + m * 16) * ldc + col0;
#pragma unroll
                for (int bj = 0; bj < 2; ++bj) { f32x4 v0 = acc[ai][bj][m][0] + bv[bj][0], v1 = acc[ai][bj][m][1] + bv[bj][1];
                    if (ACT == 1) { f32x2 a = gelu_pk((f32x2){v0[0], v0[1]}), b = gelu_pk((f32x2){v0[2], v0[3]}), c = gelu_pk((f32x2){v1[0], v1[1]}), d = gelu_pk((f32x2){v1[2], v1[3]});
                        v0 = (f32x4){a.x, a.y, b.x, b.y}; v1 = (f32x4){c.x, c.y, d.x, d.y}; }
                    v0 = v0 * sc; v1 = v1 * sc; u32x4 w; w.x = cvt_pk_bf16(v0[0], v0[1]); w.y = cvt_pk_bf16(v0[2], v0[3]); w.z = cvt_pk_bf16(v1[0], v1[1]); w.w = cvt_pk_bf16(v1[2], v1[3]);
                    *(u32x4*)(rowp + bj * HALF) = w; } }
    }
};

struct PanelStats {
    unsigned* xbuf;
    unsigned* cnt;
    unsigned* tmo;
    int ntn; float eps;
    unsigned code;
    __device__ __forceinline__ bool run(const f32x4 (&v)[2][2][4][2], const Unit& u, int wr, int wc, int fr, int fq, PG8_LAS unsigned char* lds, int wid, int lane) const {
        typedef float f32x2v __attribute__((ext_vector_type(2)));
        PG8_LAS f32x2v* P = (PG8_LAS f32x2v*)lds;
        PG8_LAS f32x2v* S = (PG8_LAS f32x2v*)(lds + 8192);
        PG8_LAS unsigned* flag = (PG8_LAS unsigned*)(lds + 8192 + 2048);
#pragma unroll
        for (int ai = 0; ai < 2; ++ai)
#pragma unroll
            for (int m = 0; m < 4; ++m) {
                float s = 0.f;
#pragma unroll
                for (int bj = 0; bj < 2; ++bj)
#pragma unroll
                    for (int n = 0; n < 2; ++n) { const f32x4 x = v[ai][bj][m][n]; s += (x[0] + x[1]) + (x[2] + x[3]); }
                s += __shfl_xor(s, 16); s += __shfl_xor(s, 32);
                const float mw = s * (1.0f / 64.0f); float q = 0.f;
#pragma unroll
                for (int bj = 0; bj < 2; ++bj)
#pragma unroll
                    for (int n = 0; n < 2; ++n) { const f32x4 d = v[ai][bj][m][n] - mw; q += (d[0] * d[0] + d[1] * d[1]) + (d[2] * d[2] + d[3] * d[3]); }
                q += __shfl_xor(q, 16); q += __shfl_xor(q, 32);
                if (fq == 0) P[(ai * HALF + wr * 64 + m * 16 + fr) * 4 + wc] = (f32x2v){mw, q};
            }
        asm volatile("s_waitcnt lgkmcnt(0)" ::: "memory"); __builtin_amdgcn_s_barrier(); asm volatile("" ::: "memory");
#if defined(BROKEN_EXCHANGE_NO_WAIT)
#warning BROKEN CONTROL BUILD: the row-statistics exchange does not wait; results are wrong by design
        if (blockIdx.x >= 64) { const long long t0_ = clock64(); while (clock64() - t0_ < 60000) __builtin_amdgcn_s_sleep(8); }
#endif
        const int row = wid * 32 + (lane & 31);
        if (lane < 32) {
            const f32x2v a = P[row * 4 + 0], b = P[row * 4 + 1], c = P[row * 4 + 2], d = P[row * 4 + 3];
            const float mt = (a.x + b.x + c.x + d.x) * 0.25f;
            const float da = a.x - mt, db = b.x - mt, dc = c.x - mt, dd = d.x - mt;
            const float m2 = (a.y + b.y) + (c.y + d.y) + 64.0f * ((da * da + db * db) + (dc * dc + dd * dd));
            unsigned long long* slot = (unsigned long long*)xbuf + ((size_t)(u.pm * BM + row) * 4 + u.pn);
            __hip_atomic_store(slot, ((unsigned long long)__float_as_uint(m2) << 32) | __float_as_uint(mt), __ATOMIC_RELAXED, __HIP_MEMORY_SCOPE_AGENT);
        }
        asm volatile("s_waitcnt vmcnt(0)" ::: "memory");
        if (lane == 0) __hip_atomic_fetch_add(cnt + 64 * u.pm, 1u, __ATOMIC_RELAXED, __HIP_MEMORY_SCOPE_AGENT);
        if (wid == 0) {
            bool dead = false; const unsigned long long t0 = __builtin_amdgcn_s_memrealtime(); const unsigned want = 8u * (unsigned)ntn;
            for (;;) {
#if defined(BROKEN_EXCHANGE_NO_WAIT)
                break;
#endif
                if ((unsigned)__builtin_amdgcn_readfirstlane(__hip_atomic_load(cnt + 64 * u.pm, __ATOMIC_RELAXED, __HIP_MEMORY_SCOPE_AGENT)) >= want) break;
                if (__builtin_amdgcn_s_memrealtime() - t0 > 2000000ull) {
                    if (lane == 0) { unsigned expect = 0u; __hip_atomic_compare_exchange_strong(tmo + 1, &expect, code | (unsigned)(u.pm & 0xff), __ATOMIC_RELAXED, __ATOMIC_RELAXED, __HIP_MEMORY_SCOPE_AGENT);
                                     __hip_atomic_store(tmo, 1u, __ATOMIC_RELAXED, __HIP_MEMORY_SCOPE_AGENT); }
                    dead = true; break; }
                __builtin_amdgcn_s_sleep(2);
            }
            __builtin_amdgcn_fence(__ATOMIC_ACQUIRE, "agent");
            if (lane == 0) flag[0] = dead ? 1u : 0u;
        }
        asm volatile("s_waitcnt vmcnt(0) lgkmcnt(0)" ::: "memory"); __builtin_amdgcn_s_barrier(); asm volatile("" ::: "memory");
        const bool bad = flag[0] != 0u;
        if (lane < 32) {
            const unsigned long long* slot = (const unsigned long long*)xbuf + (size_t)(u.pm * BM + row) * 4; float mt[4], m2[4]; float ms = 0.f;
#pragma unroll
            for (int t = 0; t < 4; ++t) { if (t < ntn) { const unsigned long long w = __hip_atomic_load(slot + t, __ATOMIC_RELAXED, __HIP_MEMORY_SCOPE_AGENT); mt[t] = __uint_as_float((unsigned)w); m2[t] = __uint_as_float((unsigned)(w >> 32)); } else { mt[t] = 0.f; m2[t] = 0.f; } ms += mt[t]; }
            const float mean = ms / (float)ntn; float q = 0.f;
#pragma unroll
            for (int t = 0; t < 4; ++t) if (t < ntn) { const float dm = mt[t] - mean; q += m2[t] + 256.0f * dm * dm; }
            S[row] = (f32x2v){mean, 1.0f / sqrtf(q / (256.0f * (float)ntn) + eps)};
        }
        asm volatile("s_waitcnt lgkmcnt(0)" ::: "memory"); __builtin_amdgcn_s_barrier(); asm volatile("" ::: "memory");
        return bad;
    }
};
struct EpiLnRes {
    static constexpr bool PERM = false, AFTER_DRAIN = true;
    const float* base; float* out; int ldc; const float* bias; PanelStats st; unsigned poison;
    __device__ __forceinline__ void fused(f32x4 (&acc)[2][2][4][2], const Unit& u, int wr, int wc, int fr, int fq, PG8_LAS unsigned char* lds, int wid, int lane) const {
        typedef float f32x2v __attribute__((ext_vector_type(2)));
        const PG8_LAS f32x2v* S = (const PG8_LAS f32x2v*)(lds + 8192);
        const int col0 = u.pn * BM + wc * 32 + 4 * fq;
#pragma unroll
        for (int bj = 0; bj < 2; ++bj)
#pragma unroll
            for (int n = 0; n < 2; ++n) { const f32x4 bv = bias ? *(const f32x4*)(bias + col0 + bj * HALF + n * 16) : (f32x4){0.f, 0.f, 0.f, 0.f};
#pragma unroll
                for (int ai = 0; ai < 2; ++ai)
#pragma unroll
                    for (int m = 0; m < 4; ++m) acc[ai][bj][m][n] += bv; }
        f32x4 pre[4][2][2];
#pragma unroll
        for (int m = 0; m < 4; ++m) { const size_t off = (size_t)(u.pm * BM + wr * 64 + m * 16 + fr) * ldc + col0;
#pragma unroll
            for (int bj = 0; bj < 2; ++bj)
#pragma unroll
                for (int n = 0; n < 2; ++n) pre[m][bj][n] = *(const f32x4*)(base + off + bj * HALF + n * 16); }
        const bool bad = st.run(acc, u, wr, wc, fr, fq, lds, wid, lane) || poison != 0u;
        const float qnan = __builtin_nanf("");
#pragma unroll
        for (int ai = 0; ai < 2; ++ai)
#pragma unroll
            for (int m = 0; m < 4; ++m) { const int r = ai * HALF + wr * 64 + m * 16 + fr; const f32x2v sr = S[r]; const size_t off = (size_t)(u.pm * BM + r) * ldc + col0;
#pragma unroll
                for (int bj = 0; bj < 2; ++bj)
#pragma unroll
                    for (int n = 0; n < 2; ++n) { const f32x4 bs = ai == 0 ? pre[m][bj][n] : *(const f32x4*)(base + off + bj * HALF + n * 16); f32x4 o = bs + (acc[ai][bj][m][n] - sr.x) * sr.y;
                        if (bad) o = (f32x4){qnan, qnan, qnan, qnan}; *(f32x4*)(out + off + bj * HALF + n * 16) = o; }
                if (m & 1) asm volatile("" ::: "memory"); }
    }
};
struct EpiLnResLn {
    static constexpr bool PERM = false, AFTER_DRAIN = true;
    const float* base; float* out; bf16_t* xn; int ldc; const float* bias; PanelStats st1, st2; unsigned poison;
    __device__ __forceinline__ void fused(f32x4 (&acc)[2][2][4][2], const Unit& u, int wr, int wc, int fr, int fq, PG8_LAS unsigned char* lds, int wid, int lane) const {
        typedef float f32x2v __attribute__((ext_vector_type(2))); typedef unsigned u32x2v __attribute__((ext_vector_type(2)));
        const PG8_LAS f32x2v* S = (const PG8_LAS f32x2v*)(lds + 8192);
        const int col0 = u.pn * BM + wc * 32 + 4 * fq;
#pragma unroll
        for (int bj = 0; bj < 2; ++bj)
#pragma unroll
            for (int n = 0; n < 2; ++n) { const f32x4 bv = bias ? *(const f32x4*)(bias + col0 + bj * HALF + n * 16) : (f32x4){0.f, 0.f, 0.f, 0.f};
#pragma unroll
                for (int ai = 0; ai < 2; ++ai)
#pragma unroll
                    for (int m = 0; m < 4; ++m) acc[ai][bj][m][n] += bv; }
        bool bad = st1.run(acc, u, wr, wc, fr, fq, lds, wid, lane) || poison != 0u;
        const float qnan = __builtin_nanf("");
#pragma unroll
        for (int ai = 0; ai < 2; ++ai)
#pragma unroll
            for (int m = 0; m < 4; ++m) { const int r = ai * HALF + wr * 64 + m * 16 + fr; const f32x2v sr = S[r]; const size_t off = (size_t)(u.pm * BM + r) * ldc + col0;
#pragma unroll
                for (int bj = 0; bj < 2; ++bj)
#pragma unroll
                    for (int n = 0; n < 2; ++n) { const f32x4 bs = *(const f32x4*)(base + off + bj * HALF + n * 16); acc[ai][bj][m][n] = bs + (acc[ai][bj][m][n] - sr.x) * sr.y; }
                asm volatile("" : "+v"(acc[ai][0][m][0]), "+v"(acc[ai][0][m][1]), "+v"(acc[ai][1][m][0]), "+v"(acc[ai][1][m][1]));
                if (m & 1) asm volatile("" ::: "memory"); }
        const bool bad1 = bad;
        bad = st2.run(acc, u, wr, wc, fr, fq, lds, wid, lane) || bad;
#pragma unroll
        for (int ai = 0; ai < 2; ++ai)
#pragma unroll
            for (int m = 0; m < 4; ++m) { const int r = ai * HALF + wr * 64 + m * 16 + fr; const f32x2v sr = S[r]; const size_t off = (size_t)(u.pm * BM + r) * ldc + col0;
#pragma unroll
                for (int bj = 0; bj < 2; ++bj)
#pragma unroll
                    for (int n = 0; n < 2; ++n) { const f32x4 x1 = acc[ai][bj][m][n]; *(f32x4*)(out + off + bj * HALF + n * 16) = bad1 ? (f32x4){qnan, qnan, qnan, qnan} : x1;
                        const f32x4 o = (x1 - sr.x) * sr.y; u32x2v w; w.x = cvt_pk_bf16(o[0], o[1]); w.y = cvt_pk_bf16(o[2], o[3]);
                        if (bad) { w.x = 0x7fc07fc0u; w.y = 0x7fc07fc0u; } *(u32x2v*)(xn + off + bj * HALF + n * 16) = w; }
                asm volatile("" ::: "memory"); }
    }
};

template <class Epi, class Sched, bool ALIGN_EPI = false, bool SP2 = false>
__device__ __forceinline__ void gemm_phase(PG8_LAS unsigned char* lds, const Gemm g, const Sched& S, const Epi& E) {
    const int tid = threadIdx.x, wid = __builtin_amdgcn_readfirstlane(tid >> 6), lane = tid & 63, wr = wid >> 2, wc = wid & 3, fr = lane & 15, fq = lane >> 4;
    const int K = g.K;
    unsigned voffA[2], voffB[2];
#pragma unroll
    for (int i = 0; i < 2; ++i) { int R, C; stage_rc(tid * 16 + i * 8192, R, C); const int Rb = Epi::PERM ? ((R & ~31) + perm32(R & 31)) : R;
        voffA[i] = (unsigned)(R * K + C) * 2u; voffB[i] = (unsigned)(Rb * K + C) * 2u; }
    const size_t kstep = (size_t)(BK * 2);
    const size_t hstep = (size_t)HALF * K * 2;
    const size_t tstep = 2 * hstep;
    const unsigned ldsw = (unsigned)wid * 1024u;
    const int aoff = lds_byte(wr * 64 + fr, fq * 8), boff = lds_byte(wc * 32 + fr, fq * 8);
#define PG8_SA(b, h) (((b) * 2 + (h)) * HTB)
#define PG8_SB(b, h) ((4 + (b) * 2 + (h)) * HTB)
#define PG8_STAGE(bufoff, gbase, voff) do { _Pragma("unroll") for (int _i = 0; _i < 2; ++_i) \
        __builtin_amdgcn_global_load_lds((const unsigned*)((const char*)(gbase) + (voff)[_i]), (PG8_LAS unsigned*)(lds + (bufoff) + ldsw + _i * 8192), 16, 0, 0); } while (0)
#define PG8_LDA(dst, b, h) do { _Pragma("unroll") for (int m = 0; m < 4; ++m) _Pragma("unroll") for (int k = 0; k < 2; ++k) dst[m][k] = *(const PG8_LAS bf16x8*)(lds + PG8_SA(b, h) + aoff + m * 2048 + k * 1024); } while (0)
#define PG8_LDB(dst, b, h) do { _Pragma("unroll") for (int n = 0; n < 2; ++n) _Pragma("unroll") for (int k = 0; k < 2; ++k) dst[n][k] = *(const PG8_LAS bf16x8*)(lds + PG8_SB(b, h) + boff + n * 2048 + k * 1024); } while (0)
#define PG8_MMA(ai, bj, At, Bt) do { __builtin_amdgcn_s_setprio(1); _Pragma("unroll") for (int m = 0; m < 4; ++m) _Pragma("unroll") for (int n = 0; n < 2; ++n) _Pragma("unroll") for (int k = 0; k < 2; ++k) \
        acc[ai][bj][m][n] = __builtin_amdgcn_mfma_f32_16x16x32_bf16(Bt[n][k], At[m][k], acc[ai][bj][m][n], 0, 0, 0); __builtin_amdgcn_s_setprio(0); } while (0)
#define PG8_WAIT_V(n) asm volatile("s_waitcnt vmcnt(" #n ")" ::: "memory")
#define PG8_WAIT_L(n) asm volatile("s_waitcnt lgkmcnt(" #n ")" ::: "memory")
#define PG8_BAR __builtin_amdgcn_s_barrier()
#define PG8_SCHED __builtin_amdgcn_sched_barrier(0)
    Unit cur, nxt; int ui = 0;
    if (!S.next(0, cur)) return;
    f32x4 acc[2][2][4][2];
#pragma unroll
    for (int a = 0; a < 2; ++a)
#pragma unroll
        for (int b = 0; b < 2; ++b)
#pragma unroll
            for (int m = 0; m < 4; ++m)
#pragma unroll
                for (int n = 0; n < 2; ++n) acc[a][b][m][n] = (f32x4){0.f, 0.f, 0.f, 0.f};
    bf16x8 At[4][2], B0[2][2], B1[2][2];
    const char* cA = (const char*)g.A + (size_t)cur.pm * tstep + (size_t)cur.kt0 * kstep; const char* cB = (const char*)g.Bt + (size_t)cur.pn * tstep + (size_t)cur.kt0 * kstep;
    int nt = cur.nkt;
    S.a_ready(cur);
    if constexpr (SP2) {
        PG8_STAGE(PG8_SB(0, 0), cB, voffB); PG8_STAGE(PG8_SB(0, 1), cB + hstep, voffB); PG8_STAGE(PG8_SA(0, 0), cA, voffA); PG8_STAGE(PG8_SA(0, 1), cA + hstep, voffA);
        if (wr == 1) PG8_BAR;
        PG8_WAIT_V(2); PG8_BAR;
        PG8_STAGE(PG8_SB(1, 0), cB + kstep, voffB); PG8_STAGE(PG8_SA(1, 0), cA + kstep, voffA); PG8_STAGE(PG8_SB(1, 1), cB + hstep + kstep, voffB);
        PG8_WAIT_V(6); PG8_BAR;
    } else {
        PG8_STAGE(PG8_SB(0, 0), cB, voffB); PG8_STAGE(PG8_SA(0, 0), cA, voffA); PG8_STAGE(PG8_SB(0, 1), cB + hstep, voffB); PG8_STAGE(PG8_SA(0, 1), cA + hstep, voffA);
        if (wr == 1) PG8_BAR;
        PG8_WAIT_V(4); PG8_BAR;
        PG8_STAGE(PG8_SB(1, 0), cB + kstep, voffB); PG8_STAGE(PG8_SA(1, 0), cA + kstep, voffA); PG8_STAGE(PG8_SB(1, 1), cB + hstep + kstep, voffB);
        PG8_WAIT_V(6); PG8_BAR;
    }
    for (;;) {
        const bool has_next = S.next(ui + 1, nxt);
        const char* nA = has_next ? (const char*)g.A + (size_t)nxt.pm * tstep + (size_t)nxt.kt0 * kstep : cA; const char* nB = has_next ? (const char*)g.Bt + (size_t)nxt.pn * tstep + (size_t)nxt.kt0 * kstep : cB;
        for (int t = 0; t < nt; t += 2) {
            const bool last = (t == nt - 2);
            const char* a1 = cA + (size_t)(t + 1) * kstep;
            const char* a2 = last ? nA : cA + (size_t)(t + 2) * kstep; const char* b2 = last ? nB : cB + (size_t)(t + 2) * kstep;
            const char* a3 = a2 + kstep; const char* b3 = b2 + kstep;
            if (last && has_next) S.a_ready(nxt);
            if constexpr (SP2) {
            PG8_LDB(B0, 0, 0); PG8_LDB(B1, 0, 1); PG8_SCHED; PG8_LDA(At, 0, 0); PG8_STAGE(PG8_SA(1, 1), a1 + hstep, voffA);
            PG8_WAIT_V(8); PG8_WAIT_L(0); PG8_BAR; PG8_MMA(0, 0, At, B0); PG8_MMA(0, 1, At, B1); PG8_BAR; PG8_SCHED;
            PG8_LDA(At, 0, 1); PG8_STAGE(PG8_SB(0, 0), b2, voffB); PG8_STAGE(PG8_SB(0, 1), b2 + hstep, voffB); PG8_STAGE(PG8_SA(0, 0), a2, voffA);
            PG8_WAIT_V(8); PG8_WAIT_L(0); PG8_BAR; PG8_MMA(1, 0, At, B0); PG8_MMA(1, 1, At, B1); PG8_BAR; PG8_SCHED;
            PG8_LDB(B0, 1, 0); PG8_LDB(B1, 1, 1); PG8_SCHED; PG8_LDA(At, 1, 0); PG8_STAGE(PG8_SA(0, 1), a2 + hstep, voffA);
            PG8_WAIT_V(8); PG8_WAIT_L(0); PG8_BAR; PG8_MMA(0, 0, At, B0); PG8_MMA(0, 1, At, B1); PG8_BAR; PG8_SCHED;
            PG8_LDA(At, 1, 1); PG8_STAGE(PG8_SB(1, 0), b3, voffB); PG8_STAGE(PG8_SB(1, 1), b3 + hstep, voffB); PG8_STAGE(PG8_SA(1, 0), a3, voffA);
            PG8_WAIT_V(8); PG8_WAIT_L(0); PG8_BAR; PG8_MMA(1, 0, At, B0); PG8_MMA(1, 1, At, B1); PG8_BAR; PG8_SCHED;
            } else {
            PG8_LDB(B0, 0, 0); PG8_SCHED; PG8_LDA(At, 0, 0); PG8_STAGE(PG8_SA(1, 1), a1 + hstep, voffA);
            PG8_WAIT_L(8); PG8_BAR; PG8_WAIT_L(0); PG8_MMA(0, 0, At, B0); PG8_BAR; PG8_SCHED;
            PG8_LDB(B1, 0, 1); PG8_STAGE(PG8_SB(0, 0), b2, voffB);
            PG8_BAR; PG8_WAIT_L(0); PG8_MMA(0, 1, At, B1); PG8_BAR;
            PG8_LDA(At, 0, 1); PG8_STAGE(PG8_SA(0, 0), a2, voffA);
            PG8_BAR; PG8_WAIT_L(0); PG8_MMA(1, 0, At, B0); PG8_BAR; PG8_SCHED;
            PG8_STAGE(PG8_SB(0, 1), b2 + hstep, voffB);
            PG8_WAIT_V(6); PG8_BAR; PG8_MMA(1, 1, At, B1); PG8_BAR;
            PG8_LDB(B0, 1, 0); PG8_SCHED; PG8_LDA(At, 1, 0); PG8_STAGE(PG8_SA(0, 1), a2 + hstep, voffA);
            PG8_WAIT_L(8); PG8_BAR; PG8_WAIT_L(0); PG8_MMA(0, 0, At, B0); PG8_BAR; PG8_SCHED;
            PG8_LDB(B1, 1, 1); PG8_STAGE(PG8_SB(1, 0), b3, voffB);
            PG8_BAR; PG8_WAIT_L(0); PG8_MMA(0, 1, At, B1); PG8_BAR;
            PG8_LDA(At, 1, 1); PG8_STAGE(PG8_SA(1, 0), a3, voffA);
            PG8_BAR; PG8_WAIT_L(0); PG8_MMA(1, 0, At, B0); PG8_BAR; PG8_SCHED;
            PG8_STAGE(PG8_SB(1, 1), b3 + hstep, voffB);
            PG8_WAIT_V(6); PG8_BAR; PG8_MMA(1, 1, At, B1); PG8_BAR;
            }
        }
        if constexpr (ALIGN_EPI) { if (wr == 0) PG8_BAR; }
        if constexpr (!Epi::AFTER_DRAIN) { E(acc, cur, wr, wc, fr, fq); S.done(cur); }
        if (!has_next) break;
#pragma unroll
        for (int a = 0; a < 2; ++a)
#pragma unroll
            for (int b = 0; b < 2; ++b)
#pragma unroll
                for (int m = 0; m < 4; ++m)
#pragma unroll
                    for (int n = 0; n < 2; ++n) acc[a][b][m][n] = (f32x4){0.f, 0.f, 0.f, 0.f};
        cur = nxt; cA = nA; cB = nB; ++ui; nt = cur.nkt;
        if constexpr (ALIGN_EPI) { if (wr == 1) PG8_BAR; }
    }
    PG8_WAIT_V(0);
    if constexpr (!ALIGN_EPI) { if (wr == 0) PG8_BAR; }
    PG8_BAR;
    if constexpr (Epi::AFTER_DRAIN) { E.fused(acc, cur, wr, wc, fr, fq, lds, wid, lane); S.done(cur); }
#undef PG8_SA
#undef PG8_SB
#undef PG8_STAGE
#undef PG8_LDA
#undef PG8_LDB
#undef PG8_MMA
#undef PG8_WAIT_V
#undef PG8_WAIT_L
#undef PG8_BAR
#undef PG8_SCHED
}
}
namespace pg8 {
__device__ __forceinline__ float silu_mul(float g, float u) { return g * __builtin_amdgcn_rcpf(1.f + __builtin_amdgcn_exp2f(-1.4426950408889634f * g)) * u; }
struct EpiSwiGLU {
    static constexpr bool PERM = true, AFTER_DRAIN = false;
    bf16_t* O; int ldc;
    __device__ __forceinline__ void operator()(const f32x4 (&acc)[2][2][4][2], const Unit& u, int wr, int wc, int fr, int fq) const {
        const int row0 = u.pm * BM + wr * 64 + fr, col0 = u.pn * HALF + wc * 32 + 8 * fq;
#pragma unroll
        for (int ai = 0; ai < 2; ++ai)
#pragma unroll
            for (int m = 0; m < 4; ++m) { bf16_t* rowp = O + (size_t)(row0 + ai * HALF + m * 16) * ldc + col0;
                const f32x4 g0 = acc[ai][0][m][0], g1 = acc[ai][0][m][1], u0 = acc[ai][1][m][0], u1 = acc[ai][1][m][1];
                u32x4 w; w.x = cvt_pk_bf16(silu_mul(g0[0], u0[0]), silu_mul(g0[1], u0[1])); w.y = cvt_pk_bf16(silu_mul(g0[2], u0[2]), silu_mul(g0[3], u0[3]));
                w.z = cvt_pk_bf16(silu_mul(g1[0], u1[0]), silu_mul(g1[1], u1[1])); w.w = cvt_pk_bf16(silu_mul(g1[2], u1[2]), silu_mul(g1[3], u1[3]));
                *(u32x4*)rowp = w; }
    }
};
struct EpiF32 {
    static constexpr bool PERM = true, AFTER_DRAIN = false;
    bf16_t* O; int ldc; float* slab; int row0s, rows_s, nkt_full;
    __device__ __forceinline__ void operator()(const f32x4 (&acc)[2][2][4][2], const Unit& u, int wr, int wc, int fr, int fq) const {
        const int row0 = u.pm * BM + wr * 64 + fr, col0 = u.pn * BM + wc * 32 + 8 * fq;
        if (u.nkt != nkt_full) {
            float* base = slab + ((size_t)(u.kt0 / SPLIT_KT) * rows_s + (row0 - row0s)) * ldc + col0;
#pragma unroll
            for (int ai = 0; ai < 2; ++ai)
#pragma unroll
                for (int m = 0; m < 4; ++m) { float* rowp = base + (size_t)(ai * HALF + m * 16) * ldc;
#pragma unroll
                    for (int bj = 0; bj < 2; ++bj)
#pragma unroll
                        for (int n = 0; n < 2; ++n) *(f32x4*)(rowp + bj * HALF + n * 4) = acc[ai][bj][m][n]; }
        } else {
            bf16_t* base = O + (size_t)row0 * ldc + col0;
#pragma unroll
            for (int ai = 0; ai < 2; ++ai)
#pragma unroll
                for (int m = 0; m < 4; ++m) { bf16_t* rowp = base + (size_t)(ai * HALF + m * 16) * ldc;
#pragma unroll
                    for (int bj = 0; bj < 2; ++bj) { const f32x4 v0 = acc[ai][bj][m][0], v1 = acc[ai][bj][m][1]; u32x4 w; w.x = cvt_pk_bf16(v0[0], v0[1]); w.y = cvt_pk_bf16(v0[2], v0[3]); w.z = cvt_pk_bf16(v1[0], v1[1]); w.w = cvt_pk_bf16(v1[2], v1[3]);
                        *(u32x4*)(rowp + bj * HALF) = w; } }
        }
    }
};
struct EpiWin {
    static constexpr bool PERM = false, AFTER_DRAIN = false;
    bf16_t* QKV; bf16_t* PR; float* kout; float* vout; float* kout_s; float* vout_s; float* shift_p; float* shift_s; float qscale; int MPr, SEQr;
    __device__ __forceinline__ void operator()(const f32x4 (&acc)[2][2][4][2], const Unit& u, int wr, int wc, int fr, int fq) const {
        typedef unsigned u32x2v __attribute__((ext_vector_type(2)));
        const int ct = u.pn, row0 = u.pm * BM + wr * 64 + fr, colt = wc * 32 + 4 * fq;
        const bool samp = (u.pm * BM) >= MPr;
#pragma unroll
        for (int ai = 0; ai < 2; ++ai)
#pragma unroll
            for (int m = 0; m < 4; ++m) { const int row = row0 + ai * HALF + m * 16;
#pragma unroll
                for (int bj = 0; bj < 2; ++bj)
#pragma unroll
                    for (int n = 0; n < 2; ++n) { const int c = ct * BM + colt + bj * HALF + n * 16; const f32x4 v = acc[ai][bj][m][n];
                        if (ct < 6) { const float sc = ct < 2 ? qscale : 1.f; u32x2v w; w.x = cvt_pk_bf16(v[0] * sc, v[1] * sc); w.y = cvt_pk_bf16(v[2] * sc, v[3] * sc);
                            *(u32x2v*)(QKV + (size_t)row * 1536 + c) = w;
                            if (ct >= 2) { float* ob = (ct < 4) ? (samp ? kout_s + (size_t)(row - MPr) * 512 : kout + (size_t)row * 512) + (c - 512)
                                                                  : (samp ? vout_s + (size_t)(row - MPr) * 512 : vout + (size_t)row * 512) + (c - 1024);
                                *(f32x4*)ob = v; } }
                        else { const int pc = c - 1536; { u32x2v w; w.x = cvt_pk_bf16(v[0], v[1]); w.y = cvt_pk_bf16(v[2], v[3]); *(u32x2v*)(PR + (size_t)row * 1792 + pc) = w; }
                            if (!samp) { if ((row & (SEQr - 1)) == SEQr - 1) *(f32x4*)(shift_p + (size_t)(row / SEQr) * 1792 + pc) = v; }
                            else { const int rs = row - MPr; if ((rs & 3) == 3) *(f32x4*)(shift_s + (size_t)(rs >> 2) * 1792 + pc) = v; } } } }
    }
};
}
#include <hip/hip_bf16.h>
#include <cmath>
namespace attn_body {
using bf16=__hip_bfloat16;
using bf16x8=__attribute__((ext_vector_type(8)))short;
using s16x4=__attribute__((ext_vector_type(4)))short;
using f32x16=__attribute__((ext_vector_type(16)))float;
using u32x4=__attribute__((ext_vector_type(4)))unsigned;
constexpr int SEQ=2048,D=64,PQ=1536,PO=1024;
constexpr int NW=8,QBLK=32,QB=QBLK*NW,KVBLK=64,NQB=SEQ/QB;
constexpr int ATTN_UNIT_ROWS=QB;
__device__ __forceinline__ int crow(int r,int hi){return (r&3)+8*(r>>2)+4*hi;}
#define SBAR() __builtin_amdgcn_sched_barrier(0)
typedef __attribute__((address_space(3))) const float* lds_cfptr;
__device__ __forceinline__ void cbias(f32x16&p0,f32x16&p1,int jb,int qrel,int hi,lds_cfptr R){
  const int nb=qrel-64*(jb-2)-4*hi; lds_cfptr rp=R+(383-nb);
  #pragma unroll
  for(int r=0;r<16;++r){const int off=(r&3)+8*(r>>2); p0[r]+=rp[off]; p1[r]+=rp[off+32];}
}

constexpr int NSLOT=3, SLOTB=8192;
constexpr int LDS_K=0, LDS_V=NSLOT*SLOTB, LDS_WS=2*NSLOT*SLOTB, LDS_OST=LDS_WS+NW*64*4, LDS_BYTES=LDS_OST+NW*4096;
constexpr float C2=0.125f*1.4426950408889634f;
__device__ __forceinline__ void glds16(const void*gsrc,unsigned lds_dst){unsigned keep;
  asm volatile("s_mov_b32 %0, m0\n\ts_mov_b32 m0, %2\n\ts_nop 0\n\tglobal_load_lds_dwordx4 %1, off\n\ts_mov_b32 m0, %0":"=&s"(keep):"v"(gsrc),"s"(lds_dst):"memory");}
__device__ __forceinline__ float max3f(float a,float b,float c){float r;asm("v_max3_f32 %0, %1, %2, %3":"=v"(r):"v"(a),"v"(b),"v"(c));return r;}
__device__ __forceinline__ float max2f(float a,float b){float r;asm("v_max_f32_e32 %0, %1, %2":"=v"(r):"v"(a),"v"(b));return r;}
__device__ __forceinline__ float fadd_s(float a,float b){float r;asm("v_add_f32_e32 %0, %1, %2":"=v"(r):"v"(a),"v"(b));return r;}
__device__ __forceinline__ float fsub_s(float a,float b){float r;asm("v_sub_f32_e32 %0, %1, %2":"=v"(r):"v"(a),"v"(b));return r;}
typedef float f32x2_t __attribute__((ext_vector_type(2))); typedef __bf16 bf16x2_t __attribute__((ext_vector_type(2)));
__device__ __forceinline__ unsigned cvtpk_s(float lo,float hi){f32x2_t v={lo,hi};bf16x2_t b=__builtin_convertvector(v,bf16x2_t);return __builtin_bit_cast(unsigned,b);}
#define WAIT_BAR(N) asm volatile("s_waitcnt vmcnt(" #N ") lgkmcnt(0)\n\ts_barrier":::"memory")

__device__ __forceinline__ void qkt(f32x16&p0,f32x16&p1,const char*Kslot,const bf16x8*qr,const f32x16&negm,int r32,int hi){
  const char*kb=Kslot+hi*1024+r32*16;
  #pragma unroll
  for(int d0=0;d0<4;++d0){
    const bf16x8 b0=*reinterpret_cast<const bf16x8*>(kb+d0*2048);
    const bf16x8 b1=*reinterpret_cast<const bf16x8*>(kb+d0*2048+512);
    if(d0==0){p0=__builtin_amdgcn_mfma_f32_32x32x16_bf16(b0,qr[0],negm,0,0,0);p1=__builtin_amdgcn_mfma_f32_32x32x16_bf16(b1,qr[0],negm,0,0,0);}
    else{p0=__builtin_amdgcn_mfma_f32_32x32x16_bf16(b0,qr[d0],p0,0,0,0);p1=__builtin_amdgcn_mfma_f32_32x32x16_bf16(b1,qr[d0],p1,0,0,0);}}
}
typedef __attribute__((address_space(3))) const char* lds_cptr;
typedef short v4i16_t __attribute__((ext_vector_type(4)));
__device__ __forceinline__ void kload8(bf16x8*kf,lds_cptr kp){
  kf[0]=*(const __attribute__((address_space(3))) bf16x8*)(kp);      kf[1]=*(const __attribute__((address_space(3))) bf16x8*)(kp+512);
  kf[2]=*(const __attribute__((address_space(3))) bf16x8*)(kp+2048); kf[3]=*(const __attribute__((address_space(3))) bf16x8*)(kp+2560);
  kf[4]=*(const __attribute__((address_space(3))) bf16x8*)(kp+4096); kf[5]=*(const __attribute__((address_space(3))) bf16x8*)(kp+4608);
  kf[6]=*(const __attribute__((address_space(3))) bf16x8*)(kp+6144); kf[7]=*(const __attribute__((address_space(3))) bf16x8*)(kp+6656);
}
__device__ __forceinline__ void kload2(bf16x8*kf,lds_cptr kp,int j){ kf[2*j]=*(const __attribute__((address_space(3))) bf16x8*)(kp+j*2048); kf[2*j+1]=*(const __attribute__((address_space(3))) bf16x8*)(kp+j*2048+512); }
__device__ __forceinline__ s16x4 vtr(lds_cptr p){ return __builtin_bit_cast(s16x4,__builtin_amdgcn_ds_read_tr16_b64_v4i16((__attribute__((address_space(3))) v4i16_t*)p)); }
__device__ __forceinline__ float rowmax(const f32x16&p0,const f32x16&p1){
  float a=max3f(p0[0],p0[1],p1[0]),b=max3f(p0[2],p0[3],p1[1]);a=max3f(a,p1[2],p1[3]);
  #pragma unroll
  for(int r=4;r<16;r+=4){a=max3f(a,p0[r],p0[r+1]);b=max3f(b,p0[r+2],p0[r+3]);a=max3f(a,p1[r],p1[r+1]);b=max3f(b,p1[r+2],p1[r+3]);}
  const float m=max2f(a,b);
  auto rr=__builtin_amdgcn_permlane32_swap(__float_as_uint(m),__float_as_uint(m),false,false);
  return max2f(__uint_as_float(rr[0]),__uint_as_float(rr[1]));
}
__device__ __forceinline__ void pv(f32x16*o,int vb,bf16x8 pa0,bf16x8 pa1,bf16x8 pa2,bf16x8 pa3){
  #pragma unroll
  for(int d0=0;d0<2;++d0){s16x4 lo[4],hi[4];
    #pragma unroll
    for(int ks=0;ks<4;++ks){
      asm volatile("ds_read_b64_tr_b16 %0,%1 offset:%c2":"=&v"(lo[ks]):"v"(vb),"i"(d0*4096+ks*1024):"memory");
      asm volatile("ds_read_b64_tr_b16 %0,%1 offset:%c2":"=&v"(hi[ks]):"v"(vb),"i"(d0*4096+ks*1024+512):"memory");}
    asm volatile("s_waitcnt lgkmcnt(0)":::"memory");SBAR();
    #define PK(k) (bf16x8){lo[k][0],lo[k][1],lo[k][2],lo[k][3],hi[k][0],hi[k][1],hi[k][2],hi[k][3]}
    o[d0]=__builtin_amdgcn_mfma_f32_32x32x16_bf16(pa0,PK(0),o[d0],0,0,0);
    o[d0]=__builtin_amdgcn_mfma_f32_32x32x16_bf16(pa1,PK(1),o[d0],0,0,0);
    o[d0]=__builtin_amdgcn_mfma_f32_32x32x16_bf16(pa2,PK(2),o[d0],0,0,0);
    o[d0]=__builtin_amdgcn_mfma_f32_32x32x16_bf16(pa3,PK(3),o[d0],0,0,0);
    #undef PK
  }
}

#ifndef ATTN_STORE16
#define ATTN_STORE16(p,v) (*(u32x4*)(p)=(v))
#endif
template<int THRL> __device__ __forceinline__ void attn_unit(int b,int qb,const bf16*Qc,const bf16*__restrict__ Kc,const bf16*__restrict__ Vc,bf16*Oc,lds_cfptr lutR,char*shm){
  const int tid=threadIdx.x,lane=tid&63,r32=lane&31,hi=lane>>5; const int wid=__builtin_amdgcn_readfirstlane(tid>>6);
  const long rowbase=(long)b*SEQ; const int q0=qb*QB;
  const bf16*Qw=Qc+(rowbase+q0+wid*QBLK)*PQ;
  const bf16*Kh=Kc+rowbase*PQ,*Vh=Vc+rowbase*PQ;
  const unsigned lds0=(unsigned)(uintptr_t)shm;
  float*wsf=(float*)(shm+LDS_WS)+wid*64;
  const bf16*ksrc=Kh+(long)lane*PQ+wid*8;
  const bf16*vsrc=Vh+(long)(16*(wid&3)+(lane>>2))*PQ+(wid>>2)*32+(lane&3)*8;
  const unsigned kdst=lds0+LDS_K+wid*1024, vdst=lds0+LDS_V+wid*1024;
  #define DMA_K(t,slot) glds16(ksrc+(long)(t)*KVBLK*PQ,(unsigned)__builtin_amdgcn_readfirstlane(kdst+(slot)))
  #define DMA_V(t,slot) glds16(vsrc+(long)(t)*KVBLK*PQ,(unsigned)__builtin_amdgcn_readfirstlane(vdst+(slot)))
  const int vb0=(int)(lds0+LDS_V)+((lane>>4)&1)*32+(lane&3)*8+(4*hi+((lane&15)>>2))*64;
  const char*Kbase=shm+LDS_K; bf16x8 kf[8];
  const lds_cptr shm3=(lds_cptr)shm; const lds_cptr kp0=shm3+LDS_K+hi*1024+r32*16; const lds_cptr vp0=shm3+LDS_V+((lane>>4)&1)*32+(lane&3)*8+(4*hi+((lane&15)>>2))*64;
  const int NT=(q0+QB)/KVBLK;
  DMA_K(0,0);DMA_V(0,0);DMA_K(1,SLOTB);
  bf16x8 qr[4];
  #pragma unroll
  for(int d0=0;d0<4;++d0)qr[d0]=*reinterpret_cast<const bf16x8*>(&Qw[(long)r32*PQ+d0*16+hi*8]);
  float mhat=0.f,l_reg=0.f;f32x16 o[2];o[0]=f32x16{};o[1]=f32x16{};f32x16 negm=f32x16{};asm volatile("":"+v"(negm));
  const int qrel=wid*QBLK+r32;
  #define CMASK(P0,P1,t) do{int jb_=(t)-(NT-6); if(jb_>=0)cbias(P0,P1,jb_,qrel,hi,lutR);}while(0)
  bool resc=false;
  #define START(P0,P1) do{ const float rm=rowmax(P0,P1); resc=false; \
    { const float dl=rm; mhat=fadd_s(mhat,dl); \
      _Pragma("unroll") for(int r=0;r<16;++r){P0[r]=fsub_s(P0[r],dl);P1[r]=fsub_s(P1[r],dl);} \
      _Pragma("unroll") for(int r=0;r<16;++r)negm[r]=-mhat; asm volatile("":"+v"(negm)); } \
    _Pragma("unroll") for(int r=0;r<16;++r)P0[r]=__builtin_amdgcn_exp2f(P0[r]); }while(0)
  #define RESC() do{ if(resc){ asm volatile("s_waitcnt lgkmcnt(0)":::"memory"); \
      _Pragma("unroll") for(int d_=0;d_<2;++d_) _Pragma("unroll") for(int r=0;r<16;++r)o[d_][r]*=wsf[crow(r,hi)]; } }while(0)
  f32x16 pA0,pA1,pB0,pB1;
  int sl_prev=0,sl_cur=0,sl_next=SLOTB;
  #define ROT() do{sl_prev=sl_cur;sl_cur=sl_next;sl_next=(sl_next==(NSLOT-1)*SLOTB)?0:sl_next+SLOTB;}while(0)
  DMA_K(2,2*SLOTB);
  WAIT_BAR(3);
  qkt(pA0,pA1,Kbase,qr,negm,r32,hi);asm volatile("s_nop 15\n\ts_nop 7":"+v"(pA0),"+v"(pA1));CMASK(pA0,pA1,0);
  START(pA0,pA1);
  _Pragma("unroll") for(int r=0;r<16;++r)pA1[r]=__builtin_amdgcn_exp2f(pA1[r]);
  WAIT_BAR(0);
  DMA_K(3,0);DMA_V(1,SLOTB);
  ROT();
  kload8(kf,kp0+sl_cur);
  WAIT_BAR(2);
  s16x4 vlo[8],vhi[8]; u32x4 pw0,pw1,pw2,pw3;
  #define PKW(P,B) cvtpk_s(P[B],P[B+1])
  #define PAF(k) __builtin_bit_cast(bf16x8,pw##k)
  #define VFR(i) (bf16x8){vlo[i][0],vlo[i][1],vlo[i][2],vlo[i][3],vhi[i][0],vhi[i][1],vhi[i][2],vhi[i][3]}
  #define PIN(x) asm volatile("":"+v"(x))
  #define MX3(a,b,c) __builtin_fmaxf(__builtin_fmaxf((a),(b)),(c))
  #define GAPA(MF,A0,A1,A2,A3,W0,W1,PW) do{ MF; sacc+=A0; sacc+=A1; sacc+=A2; sacc+=A3; PIN(sacc); W0; W1; PIN(PW); SBAR(); }while(0)
  #define EX(v) __builtin_amdgcn_exp2f(v)
  #define GAPB(MF,X,B) do{ MF; X[B]=EX(X[B]); X[B+1]=EX(X[B+1]); X[B+2]=EX(X[B+2]); X[B+3]=EX(X[B+3]); PIN(X); SBAR(); }while(0)
  #define VRD(i) do{ vlo[i]=vtr(vp_+(((i)>>2)*4096+((i)&3)*1024)); vhi[i]=vtr(vp_+(((i)>>2)*4096+((i)&3)*1024+512)); }while(0)
  #define KRD(G,j) do{ if(G){ kload2(kf,kp0+sl_next,j); SBAR(); } }while(0)
  #define STEP(C0,C1,P0,P1,t,GK,GV,GL) do{ SBAR(); \
    const lds_cptr vp_=vp0+sl_prev; \
    VRD(0); SBAR(); float sacc=(P0[0]+P0[1]); \
    GAPA(C0=__builtin_amdgcn_mfma_f32_32x32x16_bf16(kf[0],qr[0],negm,0,0,0), P0[2],P0[3],P0[4],P0[5],     pw0[0]=PKW(P0,0), pw0[1]=PKW(P0,2), pw0); \
    VRD(4); SBAR(); GAPA(C1=__builtin_amdgcn_mfma_f32_32x32x16_bf16(kf[1],qr[0],negm,0,0,0), P0[6],P0[7],P0[8],P0[9],     pw0[2]=PKW(P0,4), pw0[3]=PKW(P0,6), pw0); \
    VRD(1); SBAR(); GAPA(C0=__builtin_amdgcn_mfma_f32_32x32x16_bf16(kf[2],qr[1],C0,0,0,0),   P0[10],P0[11],P0[12],P0[13], pw1[0]=PKW(P0,8), pw1[1]=PKW(P0,10), pw1); \
    VRD(5); SBAR(); GAPA(C1=__builtin_amdgcn_mfma_f32_32x32x16_bf16(kf[3],qr[1],C1,0,0,0),   P0[14],P0[15],P1[0],P1[1],   pw1[2]=PKW(P0,12),pw1[3]=PKW(P0,14), pw1); \
    VRD(2); SBAR(); GAPA(C0=__builtin_amdgcn_mfma_f32_32x32x16_bf16(kf[4],qr[2],C0,0,0,0),   P1[2],P1[3],P1[4],P1[5],     pw2[0]=PKW(P1,0), pw2[1]=PKW(P1,2), pw2); \
    VRD(6); SBAR(); GAPA(C1=__builtin_amdgcn_mfma_f32_32x32x16_bf16(kf[5],qr[2],C1,0,0,0),   P1[6],P1[7],P1[8],P1[9],     pw2[2]=PKW(P1,4), pw2[3]=PKW(P1,6), pw2); \
    VRD(3); SBAR(); GAPA(C0=__builtin_amdgcn_mfma_f32_32x32x16_bf16(kf[6],qr[3],C0,0,0,0),   P1[10],P1[11],P1[12],P1[13], pw3[0]=PKW(P1,8), pw3[1]=PKW(P1,10), pw3); \
    VRD(7); SBAR(); GAPA(C1=__builtin_amdgcn_mfma_f32_32x32x16_bf16(kf[7],qr[3],C1,0,0,0),   P1[14],P1[15],0.f,0.f,       pw3[2]=PKW(P1,12),pw3[3]=PKW(P1,14), pw3); \
    l_reg+=sacc; \
    if(GK){DMA_K((t)+3,sl_cur);} if(GV){DMA_V((t)+1,sl_next);} \
    CMASK(C0,C1,t); \
    { float a=MX3(C0[0],C0[1],C1[0]),b=MX3(C0[2],C0[3],C1[1]); a=MX3(a,C1[2],C1[3]); \
      _Pragma("unroll") for(int r=4;r<16;r+=4){a=MX3(a,C0[r],C0[r+1]);b=MX3(b,C0[r+2],C0[r+3]);a=MX3(a,C1[r],C1[r+1]);b=MX3(b,C1[r+2],C1[r+3]);} \
      float rm=__builtin_fmaxf(a,b); { auto rr=__builtin_amdgcn_permlane32_swap(__float_as_uint(rm),__float_as_uint(rm),false,false); rm=__builtin_fmaxf(__uint_as_float(rr[0]),__uint_as_float(rr[1])); } \
      resc=false; \
      if(__builtin_expect(__any(rm>(float)THRL),0)){ const float dl=__builtin_fmaxf(rm,0.f); mhat+=dl; \
        _Pragma("unroll") for(int r=0;r<16;++r){C0[r]-=dl;C1[r]-=dl;} \
        _Pragma("unroll") for(int r=0;r<16;++r)negm[r]=-mhat; asm volatile("":"+v"(negm)); \
        const float f=__builtin_amdgcn_exp2f(-dl); l_reg*=f; if(hi==0)wsf[r32]=f; resc=true; } } \
    SBAR(); \
    GAPB(o[0]=__builtin_amdgcn_mfma_f32_32x32x16_bf16(PAF(0),VFR(0),o[0],0,0,0), C0,0); \
    GAPB(o[1]=__builtin_amdgcn_mfma_f32_32x32x16_bf16(PAF(0),VFR(4),o[1],0,0,0), C0,4); \
    KRD(GL,0); GAPB(o[0]=__builtin_amdgcn_mfma_f32_32x32x16_bf16(PAF(1),VFR(1),o[0],0,0,0), C0,8); \
    KRD(GL,1); GAPB(o[1]=__builtin_amdgcn_mfma_f32_32x32x16_bf16(PAF(1),VFR(5),o[1],0,0,0), C0,12); \
    KRD(GL,2); GAPB(o[0]=__builtin_amdgcn_mfma_f32_32x32x16_bf16(PAF(2),VFR(2),o[0],0,0,0), C1,0); \
    KRD(GL,3); GAPB(o[1]=__builtin_amdgcn_mfma_f32_32x32x16_bf16(PAF(2),VFR(6),o[1],0,0,0), C1,4); \
    GAPB(o[0]=__builtin_amdgcn_mfma_f32_32x32x16_bf16(PAF(3),VFR(3),o[0],0,0,0), C1,8); \
    GAPB(o[1]=__builtin_amdgcn_mfma_f32_32x32x16_bf16(PAF(3),VFR(7),o[1],0,0,0), C1,12); \
    }while(0)
  int t=1;
  #undef CMASK
  #define CMASK(P0,P1,t) do{}while(0)
  for(;t+7<NT;t+=2){
    STEP(pB0,pB1,pA0,pA1,t,true,true,true);     WAIT_BAR(2); RESC(); ROT();
    STEP(pA0,pA1,pB0,pB1,t+1,true,true,true);   WAIT_BAR(2); RESC(); ROT();
  }
  #undef CMASK
  #define CMASK(P0,P1,t) do{int jb_=(t)-(NT-6); if(jb_>=0)cbias(P0,P1,jb_,qrel,hi,lutR);}while(0)
  #define ENDW(tt) do{ if((tt)+3<NT){WAIT_BAR(2);} else if((tt)+2<NT){WAIT_BAR(1);} else {WAIT_BAR(0);} }while(0)
  for(;t+1<NT;t+=2){
    STEP(pB0,pB1,pA0,pA1,t,(t+3<NT),(t+1<NT),(t+1<NT));       ENDW(t);   RESC(); ROT();
    STEP(pA0,pA1,pB0,pB1,t+1,(t+4<NT),(t+2<NT),(t+2<NT));     ENDW(t+1); RESC(); ROT();
  }
  STEP(pB0,pB1,pA0,pA1,NT-1,false,false,false); RESC();
  { float sacc=pB0[0]+pB0[1]; _Pragma("unroll") for(int r=2;r<16;++r)sacc+=pB0[r]; _Pragma("unroll") for(int r=0;r<16;++r)sacc+=pB1[r]; l_reg+=sacc;
    pw0=(u32x4){PKW(pB0,0),PKW(pB0,2),PKW(pB0,4),PKW(pB0,6)};pw1=(u32x4){PKW(pB0,8),PKW(pB0,10),PKW(pB0,12),PKW(pB0,14)};pw2=(u32x4){PKW(pB1,0),PKW(pB1,2),PKW(pB1,4),PKW(pB1,6)};pw3=(u32x4){PKW(pB1,8),PKW(pB1,10),PKW(pB1,12),PKW(pB1,14)};
    SBAR(); pv(o,vb0+sl_cur,PAF(0),PAF(1),PAF(2),PAF(3)); }
  #undef PKW
  #undef PAF
  #undef VFR
  #undef PIN
  #undef MX3
  #undef GAPA
  #undef GAPB
  #undef EX
  #undef VRD
  #undef KRD
  #undef STEP
  #undef ENDW
  {auto rr=__builtin_amdgcn_permlane32_swap(__float_as_uint(l_reg),__float_as_uint(l_reg),false,false);l_reg=__uint_as_float(rr[0])+__uint_as_float(rr[1]);}
  if(hi==0)wsf[32+r32]=l_reg;asm volatile("s_waitcnt lgkmcnt(0)":::"memory");
  float rli[16];
  #pragma unroll
  for(int r=0;r<16;++r)rli[r]=__builtin_amdgcn_rcpf(wsf[32+crow(r,hi)]);
  bf16*Ow=Oc+(rowbase+q0+wid*QBLK)*PO;
  { bf16*stg=(bf16*)(shm+LDS_OST)+wid*2048;
    #pragma unroll
    for(int r=0;r<16;++r){const int orow=crow(r,hi);
      #pragma unroll
      for(int d0=0;d0<2;++d0)stg[orow*64+d0*32+r32]=__float2bfloat16(o[d0][r]*rli[r]);}
    asm volatile("s_waitcnt lgkmcnt(0)":::"memory");
    #pragma unroll
    for(int i=0;i<4;++i){const int row=i*8+(lane>>3),ch=lane&7; const u32x4 v=*(const u32x4*)(stg+row*64+ch*8); ATTN_STORE16(Ow+(long)row*PO+ch*8,v);} }
  asm volatile("s_waitcnt lgkmcnt(0)\n\ts_barrier":::"memory");
  #undef DMA_K
  #undef DMA_V
  #undef CMASK
  #undef START
  #undef RESC
  #undef ROT
}
constexpr int ATTN_LDS_BYTES=LDS_BYTES;
#undef SBAR
#undef WAIT_BAR
}
#define GAS __attribute__((address_space(1)))
#define LAS __attribute__((address_space(3)))
typedef unsigned short bf16;
typedef unsigned v4u __attribute__((ext_vector_type(4)));
typedef float f32x4 __attribute__((ext_vector_type(4)));
typedef short bf16x8 __attribute__((ext_vector_type(8)));
typedef GAS unsigned gu32;
typedef GAS unsigned long long gu64;
#define RLX_AGENT __ATOMIC_RELAXED, __HIP_MEMORY_SCOPE_AGENT
#define LDS_WAIT() asm volatile("s_waitcnt lgkmcnt(0)" ::: "memory")
#define VM_WAIT() asm volatile("s_waitcnt vmcnt(0)" ::: "memory")
__device__ __forceinline__ unsigned long long rt() { return __builtin_amdgcn_s_memrealtime(); }
__device__ __forceinline__ unsigned f2bf(float f) { unsigned u = __builtin_bit_cast(unsigned, f); return (u + 0x7fffu + ((u >> 16) & 1u)) >> 16; }
__device__ __forceinline__ unsigned pk2(float lo, float hi) { return f2bf(lo) | (f2bf(hi) << 16); }

#define XB_TMO      128
#define XB_XCNT(j)  (256  + 64 * (j))
#define XB_XSUB(j)  (1280 + 64 * (j))
#define XB_XGEN(j)  (2304 + 64 * (j))
#define XB_TOP      3328
#define XB_TOPGEN   3392
#define XCD_BAR_WORDS 3456
#define XB_SPIN_CAP (1u << 18)

__device__ __forceinline__ unsigned xb_ld(unsigned* p)              { return __hip_atomic_load(p, __ATOMIC_RELAXED, __HIP_MEMORY_SCOPE_AGENT); }
__device__ __forceinline__ unsigned xb_add(unsigned* p, unsigned v) { return __hip_atomic_fetch_add(p, v, __ATOMIC_RELAXED, __HIP_MEMORY_SCOPE_AGENT); }
__device__ __forceinline__ unsigned xb_xcc_id() { return (unsigned)__builtin_amdgcn_s_getreg((3 << 11) | 20) & 0xFu; }
#define XB_SPIN(cond, bar) do { unsigned _sp = 0; while (cond) { __builtin_amdgcn_s_sleep(1); \
    if ((++_sp & 255u) == 0u) { if (xb_ld(&(bar)[XB_TMO])) break; if (_sp > XB_SPIN_CAP) { atomicAdd(&(bar)[XB_TMO], 1u); break; } } } } while (0)

struct XcdBarrier {
    unsigned* bar; unsigned x;
    volatile LAS unsigned* st;
};

__device__ __forceinline__ XcdBarrier xcd_barrier_post(unsigned* bar, volatile LAS unsigned* st) {
    XcdBarrier b; b.bar = bar; b.x = xb_xcc_id(); b.st = st;
    if (threadIdx.x == 0) (void)xb_add(&bar[XB_XCNT(b.x)], 1u);
    return b;
}
__device__ __forceinline__ void xcd_barrier_complete(unsigned* bar, unsigned x, unsigned& nloc, unsigned& nx) {
    const unsigned G = gridDim.x * gridDim.y * gridDim.z;
    unsigned sum, cnt, mine, sp = 0u;
    for (;;) {
        sum = 0u; cnt = 0u; mine = 0u;
#pragma unroll
        for (unsigned j = 0; j < 16; ++j) { const unsigned c = xb_ld(&bar[XB_XCNT(j)]); sum += c; cnt += (c > 0u) ? 1u : 0u; mine = (j == x) ? c : mine; }
        if (sum == G) break;
        __builtin_amdgcn_s_sleep(1);
        if ((++sp & 255u) == 0u) { if (xb_ld(&bar[XB_TMO])) break; if (sp > XB_SPIN_CAP) { atomicAdd(&bar[XB_TMO], 1u); break; } }
    }
    nloc = mine > 0u ? mine : 1u; nx = cnt > 0u ? cnt : 1u;
}

__device__ __forceinline__ void xcd_barrier(const XcdBarrier& b) {
    asm volatile("s_waitcnt vmcnt(0)" ::: "memory");
    __syncthreads();
    if (threadIdx.x == 0) {
        unsigned* bar = b.bar;
        __builtin_amdgcn_s_waitcnt(0);
        unsigned nloc = b.st[0], nx = b.st[1];
        if (nloc == 0u) { xcd_barrier_complete(bar, b.x, nloc, nx); b.st[0] = nloc; b.st[1] = nx; }
        const unsigned old = xb_add(&bar[XB_XSUB(b.x)], 1u);
        const unsigned gen = old / nloc;
        if (old + 1u == (gen + 1u) * nloc) {
            __builtin_amdgcn_fence(__ATOMIC_RELEASE, "agent");
            asm volatile("s_waitcnt vmcnt(0)" ::: "memory");
            const unsigned og = xb_add(&bar[XB_TOP], 1u);
            const unsigned tg = og / nx;
            if (og + 1u == (tg + 1u) * nx) xb_add(&bar[XB_TOPGEN], 1u);
            else XB_SPIN(xb_ld(&bar[XB_TOPGEN]) == tg, bar);
            __builtin_amdgcn_fence(__ATOMIC_ACQUIRE, "agent");
            xb_add(&bar[XB_XGEN(b.x)], 1u);
            asm volatile("s_waitcnt vmcnt(0)" ::: "memory");
        } else {
            XB_SPIN(xb_ld(&bar[XB_XGEN(b.x)]) == gen, bar);
            __builtin_amdgcn_fence(__ATOMIC_ACQUIRE, "agent");
            asm volatile("s_waitcnt vmcnt(0)" ::: "memory");
        }
    }
    __syncthreads();
}
constexpr int NWAVES = 8;
constexpr int DM = 1024, NB = 8, SEQ = 2048, MP = NB * SEQ, DECB = 128, DECS = 4, MS = DECB * DECS, M = MP + MS;
constexpr int RH = 8, RW = 512, RCOLS = 1792, PCOLS = 3328, DFF = 2816, NPG = 16, PAGE = 128;
constexpr float NORM_EPS = 1e-6f, SUBLN_EPS = 1e-5f, GN_EPS = 64e-5f, LAM_INIT = 0.2f;
constexpr float LOG2E = 1.4426950408889634f;
constexpr float QSCALE = 0.125f * LOG2E;
#ifndef MK_PER_PHASE
#define MK_PER_PHASE 0
#endif
constexpr int NPHASE = 13;
constexpr size_t OUT_Y = 0, OUT_KP = (size_t)M * DM, OUT_VP = OUT_KP + (size_t)MP * 512, OUT_KS = OUT_VP + (size_t)MP * 512, OUT_VS = OUT_KS + (size_t)MS * 512,
                 OUT_WP = OUT_VS + (size_t)MS * 512, OUT_WS = OUT_WP + (size_t)NB * RH * 4096, OUT_SP = OUT_WS + (size_t)DECB * RH * 4096, OUT_SS = OUT_SP + (size_t)NB * RCOLS, OUT_END = OUT_SS + (size_t)DECB * RCOLS;
constexpr size_t MiB = 1u << 20;
constexpr size_t WS_CTL = 0, CTL_ZERO_BYTES = 1 * MiB, WS_ZERO = 512 * 1024;
constexpr size_t WS_FF1IN = 2 * MiB, WS_FF1OUT = 14 * MiB, WS_FF2IN = 20 * MiB, WS_FF2OUT = 32 * MiB, WS_WIN = 38 * MiB, WS_WOUT = 45 * MiB, WS_LORA = 47 * MiB;
constexpr size_t WS_XN = 48 * MiB, WS_H = 82 * MiB, WS_F = 174 * MiB, WS_HRES = 240 * MiB, WS_QKV = 306 * MiB, WS_PR = 356 * MiB, WS_SI = 472 * MiB, WS_G = 670 * MiB,
                 WS_Y = 703 * MiB, WS_O = 736 * MiB, WS_XM = 768 * MiB, WS_BONUS = 801 * MiB, WS_SLAB = 802 * MiB, WS_DPO = 826 * MiB, WS_DPM = 843 * MiB, WS_END = 844 * MiB;
static_assert(WS_FF1IN + (size_t)2 * DFF * DM * 2 <= WS_FF1OUT && WS_FF1OUT + (size_t)DM * DFF * 2 <= WS_FF2IN && WS_FF2IN + (size_t)2 * DFF * DM * 2 <= WS_FF2OUT && WS_FF2OUT + (size_t)DM * DFF * 2 <= WS_WIN, "ws map 1");
static_assert(WS_WIN + (size_t)PCOLS * DM * 2 <= WS_WOUT && WS_WOUT + (size_t)DM * DM * 2 <= WS_LORA && WS_LORA + 256 * 1024 <= WS_XN && WS_XN + (size_t)M * DM * 2 <= WS_H && WS_H + (size_t)M * DFF * 2 <= WS_F, "ws map 2");
static_assert(WS_F + (size_t)M * DM * 4 <= WS_HRES && WS_HRES + (size_t)M * DM * 4 <= WS_QKV && WS_QKV + (size_t)M * 1536 * 2 <= WS_PR && WS_PR + (size_t)M * RCOLS * 4 <= WS_SI && WS_SI + (size_t)M * RH * 384 * 4 <= WS_G, "ws map 3");
static_assert(WS_G + (size_t)M * 512 * 4 <= WS_Y && WS_Y + (size_t)M * 512 * 4 <= WS_O && WS_O + (size_t)MP * 1024 * 2 <= WS_XM && WS_XM + (size_t)M * DM * 2 <= WS_BONUS && WS_BONUS + (size_t)M * RH * 4 <= WS_END, "ws map 4");
constexpr size_t SI_S0 = (size_t)NB * RH * SEQ * 384;
constexpr int CW_TMO = 0, CW_CODE = 1, CW_BAR = 4096;
static_assert((CW_BAR + XCD_BAR_WORDS) * 4 <= (int)WS_ZERO, "CTL words");
constexpr int RING_OFF = 0, RING_BYTES = 131072, LDSCTL_OFF = RING_BYTES, MISC_OFF = LDSCTL_OFF + 320, LDS_BYTES = 147456;
constexpr int LUTR_OFF = LDSCTL_OFF + 512;
constexpr int LUTD_OFF = LUTR_OFF + 4 * 640 * 4;
static_assert(attn_body::ATTN_LDS_BYTES <= RING_BYTES && LUTD_OFF + 4 * 128 * 4 <= LDS_BYTES && MISC_OFF + 128 <= LUTR_OFF, "LDS map");

struct Frame {
    LAS unsigned char* lds; volatile LAS unsigned* MISC; gu32* ctl;
    int tid, lane, wave, vcu, G;
    const float *x_p, *x_s, *cache_k, *cache_v; const int* page_table; const float *state_wkv, *state_shift, *gains, *ff1_in, *ff1_out, *ff2_in, *ff2_out, *w_in, *w_out, *rel_tab;
    const float *lq1, *lk1, *lq2, *lk2, *subln, *mu, *w0, *w2, *a0, *a2, *g2, *kkp, *ka, *rk, *gn_w, *gn_b;
    float* out;
    unsigned char* ws;
};
typedef float f32x2 __attribute__((ext_vector_type(2)));
__device__ __forceinline__ float wave_sum(float v) {
#pragma unroll
    for (int o = 1; o < 64; o <<= 1) v += __shfl_xor(v, o);
    return v;
}
template <int CTRL> __device__ __forceinline__ float dpp_mov(float x) { return __builtin_bit_cast(float, __builtin_amdgcn_update_dpp(0, __builtin_bit_cast(int, x), CTRL, 0xF, 0xF, true)); }
__device__ __forceinline__ float red16(float x) {
    x += dpp_mov<0xB1>(x); x += dpp_mov<0x4E>(x); x += dpp_mov<0x141>(x); x += dpp_mov<0x140>(x); return x; }
__device__ __forceinline__ float red8(float x) { x += dpp_mov<0xB1>(x); x += dpp_mov<0x4E>(x); x += dpp_mov<0x141>(x); return x; }
__device__ __forceinline__ float xsum16(float x) { auto rr = __builtin_amdgcn_permlane16_swap(__float_as_uint(x), __float_as_uint(x), false, false); return __uint_as_float(rr[0]) + __uint_as_float(rr[1]); }
__device__ __forceinline__ float xsum32(float x) { auto rr = __builtin_amdgcn_permlane32_swap(__float_as_uint(x), __float_as_uint(x), false, false); return __uint_as_float(rr[0]) + __uint_as_float(rr[1]); }
__device__ __forceinline__ float xmax16(float x) { auto rr = __builtin_amdgcn_permlane16_swap(__float_as_uint(x), __float_as_uint(x), false, false); return fmaxf(__uint_as_float(rr[0]), __uint_as_float(rr[1])); }
__device__ __forceinline__ float xmax32(float x) { auto rr = __builtin_amdgcn_permlane32_swap(__float_as_uint(x), __float_as_uint(x), false, false); return fmaxf(__uint_as_float(rr[0]), __uint_as_float(rr[1])); }
__device__ __forceinline__ float red32(float x) { return xsum16(red16(x)); }
__device__ __forceinline__ bf16x8 pack8(const float* v) { v4u w; w.x = pg8::cvt_pk_bf16(v[0], v[1]); w.y = pg8::cvt_pk_bf16(v[2], v[3]); w.z = pg8::cvt_pk_bf16(v[4], v[5]); w.w = pg8::cvt_pk_bf16(v[6], v[7]); return __builtin_bit_cast(bf16x8, w); }
__device__ __forceinline__ float sigm(float x) { return __builtin_amdgcn_rcpf(1.f + __builtin_amdgcn_exp2f(-LOG2E * x)); }
__device__ __forceinline__ float tanh_f(float x) { return 1.f - 2.f * __builtin_amdgcn_rcpf(1.f + __builtin_amdgcn_exp2f(2.f * LOG2E * x)); }
__device__ __forceinline__ float compute_lam(const Frame& F) {
    const float d1 = wave_sum(F.lq1[F.lane] * F.lk1[F.lane]), d2 = wave_sum(F.lq2[F.lane] * F.lk2[F.lane]);
    return __expf(d1) - __expf(d2) + LAM_INIT;
}
__device__ __forceinline__ float bias_delta(const float* tab, int n, int h) {
    int bucket;
    if (n < 16) bucket = n;
    else { const int lg = 16 + (int)(logf((float)n / 16.0f) / 2.0794415416798357f * 16.0f); bucket = lg < 31 ? lg : 31; }
    return (tab[bucket * 4 + h] - tab[31 * 4 + h]) * LOG2E;
}

__device__ __forceinline__ void p0_transpose_item(const float* W, int K, int N, bf16* WT, int dst_row0, LAS float* scr, int k0, int n0, int lane) {
#pragma unroll 8
    for (int i = 0; i < 32; ++i) { const int kk = 2 * i + (lane >> 5); scr[kk * 33 + (lane & 31)] = W[(size_t)(k0 + kk) * N + n0 + (lane & 31)]; }
    LDS_WAIT(); asm volatile("" ::: "memory");
    const int c = lane & 7;
#pragma unroll
    for (int j = 0; j < 4; ++j) { const int n = (lane >> 3) + 8 * j; const LAS float* s = scr + (8 * c) * 33 + n;
        v4u o; o.x = pk2(s[0 * 33], s[1 * 33]); o.y = pk2(s[2 * 33], s[3 * 33]); o.z = pk2(s[4 * 33], s[5 * 33]); o.w = pk2(s[6 * 33], s[7 * 33]);
        *(GAS v4u*)(WT + (size_t)(dst_row0 + n) * K + k0 + 8 * c) = o; }
    LDS_WAIT(); asm volatile("" ::: "memory");
}
__device__ __forceinline__ const float* xrow_ptr(const Frame& F, int m) { return m < MP ? F.x_p + (size_t)m * DM : F.x_s + (size_t)(m - MP) * DM; }
__device__ __forceinline__ void p0_prologue(Frame& F) {
    LAS float* scr = (LAS float*)(F.lds + RING_OFF + F.wave * 16384);
    const int gw = F.vcu * NWAVES + F.wave, NGW = F.G * NWAVES;
    constexpr int I_FI = (DM / 64) * (2 * DFF / 32), I_FO = (DFF / 64) * (DM / 32), I_WI = (DM / 64) * (PCOLS / 32), I_WO = (DM / 64) * (DM / 32), I_L64 = 16, I_L128 = 32;
    constexpr int NITEMS = 2 * I_FI + 2 * I_FO + I_WI + I_WO + 2 * I_L64 + I_L128;
    for (int it = gw; it < NITEMS; it += NGW) {
        int r = it;
        if (r < 2 * I_FI) { const bool second = r >= I_FI; if (second) r -= I_FI; const int nblk = 2 * DFF / 32, kb = r / nblk, nb = r % nblk, n0 = 32 * nb;
            const int j = n0 < DFF ? n0 : n0 - DFF, drow = 256 * (j / 128) + (n0 < DFF ? 0 : 128) + (j % 128);
            p0_transpose_item(second ? F.ff2_in : F.ff1_in, DM, 2 * DFF, second ? ((bf16*)(F.ws + WS_FF2IN)) : ((bf16*)(F.ws + WS_FF1IN)), drow, scr, 64 * kb, n0, F.lane); continue; }
        r -= 2 * I_FI;
        if (r < 2 * I_FO) { const bool second = r >= I_FO; if (second) r -= I_FO; const int nblk = DM / 32, kb = r / nblk, nb = r % nblk;
            p0_transpose_item(second ? F.ff2_out : F.ff1_out, DFF, DM, second ? ((bf16*)(F.ws + WS_FF2OUT)) : ((bf16*)(F.ws + WS_FF1OUT)), 32 * nb, scr, 64 * kb, 32 * nb, F.lane); continue; }
        r -= 2 * I_FO;
        if (r < I_WI) { const int nblk = PCOLS / 32, kb = r / nblk, nb = r % nblk; p0_transpose_item(F.w_in, DM, PCOLS, ((bf16*)(F.ws + WS_WIN)), 32 * nb, scr, 64 * kb, 32 * nb, F.lane); continue; }
        r -= I_WI;
        if (r < I_WO) { const int nblk = DM / 32, kb = r / nblk, nb = r % nblk; p0_transpose_item(F.w_out, DM, DM, ((bf16*)(F.ws + WS_WOUT)), 32 * nb, scr, 64 * kb, 32 * nb, F.lane); continue; }
        r -= I_WO;
        if (r < I_L64) { p0_transpose_item(F.w2, 64, RW, ((bf16*)(F.ws + WS_LORA)), 32 * r, scr, 0, 32 * r, F.lane); continue; }
        r -= I_L64;
        if (r < I_L64) { p0_transpose_item(F.a2, 64, RW, ((bf16*)(F.ws + WS_LORA) + 512 * 64), 32 * r, scr, 0, 32 * r, F.lane); continue; }
        r -= I_L64;
        { const int kb = r / 16, nb = r % 16; p0_transpose_item(F.g2, 128, RW, ((bf16*)(F.ws + WS_LORA) + 2 * 512 * 64), 32 * nb, scr, 64 * kb, 32 * nb, F.lane); }
    }
    for (int i = gw * 64 + F.lane; i < 129 * RCOLS / 4; i += NGW * 64) { const int rrow = (4 * i) / RCOLS; f32x4 v = {0.f, 0.f, 0.f, 0.f}; if (rrow < 128) v = *(const GAS f32x4*)(F.state_shift + 4 * (size_t)i);
        *(GAS unsigned long long*)(((bf16*)(F.ws + WS_PR)) + (size_t)M * RCOLS + 4 * (size_t)i) = (unsigned long long)pk2(v.x, v.y) | ((unsigned long long)pk2(v.z, v.w) << 32); }
    const GAS f32x4* gp = (const GAS f32x4*)(F.gains) + F.lane;
    for (int m = gw; m < M; m += NGW) {
        const GAS f32x4* xr = (const GAS f32x4*)xrow_ptr(F, m) + F.lane;
        f32x4 v[4]; float s = 0.f;
#pragma unroll
        for (int j = 0; j < 4; ++j) { v[j] = xr[64 * j]; s += (v[j].x * v[j].x + v[j].y * v[j].y) + (v[j].z * v[j].z + v[j].w * v[j].w); }
        const float rstd = 1.0f / sqrtf(wave_sum(s) * (1.f / DM) + NORM_EPS);
        GAS unsigned long long* o8 = (GAS unsigned long long*)(((bf16*)(F.ws + WS_XN)) + (size_t)m * DM) + F.lane;
#pragma unroll
        for (int j = 0; j < 4; ++j) { const f32x4 g = gp[64 * j]; o8[64 * j] = (unsigned long long)pk2(v[j].x * rstd * g.x, v[j].y * rstd * g.y) | ((unsigned long long)pk2(v[j].z * rstd * g.z, v[j].w * rstd * g.w) << 32); }
    }
}
template <bool HAS_XN, int NSPLIT> __device__ __forceinline__ void rowwise_phase(Frame& F, const float* base_p, const float* base_s, float* outp, const float* ga, float scale, const float* gb) {
    const int gw = F.vcu * NWAVES + F.wave, NGW = F.G * NWAVES;
    const GAS f32x4* gap = (const GAS f32x4*)ga + F.lane; const GAS f32x4* gbp = (const GAS f32x4*)gb + F.lane;
    for (int m = gw; m < M; m += NGW) {
        const GAS f32x4* br = (const GAS f32x4*)(m < MP ? base_p + (size_t)m * DM : base_s + (size_t)(m - MP) * DM) + F.lane;
        f32x4 f[4], bsv[4]; float s = 0.f;
        if (m < MP) { const GAS unsigned long long* fr = (const GAS unsigned long long*)(((bf16*)(F.ws + WS_F)) + (size_t)m * DM) + F.lane;
#pragma unroll
            for (int j = 0; j < 4; ++j) { const unsigned long long q = fr[64 * j]; const unsigned lo = (unsigned)q, hi = (unsigned)(q >> 32);
                f[j] = (f32x4){__uint_as_float(lo << 16), __uint_as_float(lo & 0xffff0000u), __uint_as_float(hi << 16), __uint_as_float(hi & 0xffff0000u)}; } }
        else {
            const GAS f32x4* fr = (const GAS f32x4*)(((float*)(F.ws + WS_SLAB)) + (size_t)(m - MP) * DM) + F.lane;
#pragma unroll
            for (int j = 0; j < 4; ++j) f[j] = fr[64 * j];
#pragma unroll
            for (int ks = 1; ks < NSPLIT; ++ks) { const GAS f32x4* fk = fr + (size_t)ks * MS * DM / 4;
#pragma unroll
                for (int j = 0; j < 4; ++j) f[j] += fk[64 * j]; }
        }
#pragma unroll
        for (int j = 0; j < 4; ++j) { bsv[j] = br[64 * j]; s += (f[j].x * f[j].x + f[j].y * f[j].y) + (f[j].z * f[j].z + f[j].w * f[j].w); }
        const float rstd = scale / sqrtf(wave_sum(s) * (1.f / DM) + NORM_EPS);
        GAS f32x4* orow = (GAS f32x4*)(outp + (size_t)m * DM) + F.lane; float s2 = 0.f;
#pragma unroll
        for (int j = 0; j < 4; ++j) { const f32x4 g = gap[64 * j]; f32x4 o = bsv[j] + f[j] * rstd * g; orow[64 * j] = o; f[j] = o; s2 += (o.x * o.x + o.y * o.y) + (o.z * o.z + o.w * o.w); }
        if (HAS_XN) {
            const float r2 = 1.0f / sqrtf(wave_sum(s2) * (1.f / DM) + NORM_EPS);
            GAS unsigned long long* o8 = (GAS unsigned long long*)(((bf16*)(F.ws + WS_XN)) + (size_t)m * DM) + F.lane;
#pragma unroll
            for (int j = 0; j < 4; ++j) { const f32x4 g = gbp[64 * j]; o8[64 * j] = (unsigned long long)pk2(f[j].x * r2 * g.x, f[j].y * r2 * g.y) | ((unsigned long long)pk2(f[j].z * r2 * g.z, f[j].w * r2 * g.w) << 32); }
        }
    }
}
__device__ __forceinline__ f32x4 ldbf4(const bf16* p) { const unsigned long long q = *(const GAS unsigned long long*)p; const unsigned lo = (unsigned)q, hi = (unsigned)(q >> 32);
    return (f32x4){__uint_as_float(lo << 16), __uint_as_float(lo & 0xffff0000u), __uint_as_float(hi << 16), __uint_as_float(hi & 0xffff0000u)}; }
__device__ __forceinline__ void prep_phase(Frame& F) {
    const int lane = F.lane, fr = lane & 15, fq = lane >> 4, h = F.wave, tid = F.tid;
    const bf16* PRb = (const bf16*)(F.ws + WS_PR);
    constexpr int XLS = 264;
    LAS bf16* XL = (LAS bf16*)(F.lds + RING_OFF);
    LAS float* PAR = (LAS float*)(F.lds + RING_OFF + 2 * 16 * XLS * 2 + 64);
    for (int i = tid; i < 8 * 512; i += NWAVES * 64) { const int a = i >> 9, c = i & 511;
        PAR[i] = a == 0 ? F.mu[c] : a == 1 ? F.mu[512 + c] : a == 2 ? F.mu[1024 + c] : a == 3 ? F.w0[c] : a == 4 ? F.a0[c] : a == 5 ? F.kkp[c] : a == 6 ? F.ka[c] : F.rk[c]; }
    const int s1tok = tid >> 5, s1ch = tid & 31;
    const f32x4 mu0 = *(const GAS f32x4*)(F.mu + 1536 + 8 * s1ch), mu1 = *(const GAS f32x4*)(F.mu + 1536 + 8 * s1ch + 4);
    const float fa = s1ch < 8 ? 2.f : 1.f, fs = s1ch < 8 ? 2.f : 1.f, fc = s1ch < 8 ? -1.f : 0.f; const bool ident = (s1ch >= 8 && s1ch < 16);
    __syncthreads();
    int buf = 0;
    for (int tile = F.vcu; tile < M / 16; tile += F.G, buf ^= 1) {
        { const int m1 = tile * 16 + s1tok; int pr1;
          if (m1 < MP) pr1 = (m1 & (SEQ - 1)) ? m1 - 1 : M + 128; else { const int ms = m1 - MP; pr1 = (ms & 3) ? m1 - 1 : M + (ms >> 2); }
          const bf16* cu = PRb + (size_t)m1 * RCOLS; const bf16* pv = PRb + (size_t)pr1 * RCOLS; const int c = 1536 + 8 * s1ch;
          const f32x4 c0 = ldbf4(cu + c), c1 = ldbf4(cu + c + 4), p0 = ldbf4(pv + c), p1 = ldbf4(pv + c + 4);
          const f32x4 x0 = c0 + (p0 - c0) * mu0, x1 = c1 + (p1 - c1) * mu1; float e[8];
#pragma unroll
          for (int i = 0; i < 4; ++i) { e[i] = ident ? x0[i] : sigm(fa * x0[i]) * fs + fc; e[4 + i] = ident ? x1[i] : sigm(fa * x1[i]) * fs + fc; }
          *(LAS bf16x8*)(XL + (buf * 16 + s1tok) * XLS + 8 * s1ch) = pack8(e); }
        __syncthreads();
        const int m = tile * 16 + fr; int t, b, prow; size_t sioff;
        if (m < MP) { t = m & (SEQ - 1); b = m >> 11; prow = t ? m - 1 : M + 128; sioff = ((size_t)(b * RH + h) * SEQ + t) * 384; }
        else { const int ms = m - MP; t = ms & 3; b = ms >> 2; prow = t ? m - 1 : M + b; sioff = SI_S0 + ((size_t)(b * RH + h) * DECS + t) * 384; }
        const bf16* curp = PRb + (size_t)m * RCOLS; const bf16* prevp = PRb + (size_t)prow * RCOLS;
        const LAS bf16* xrow = XL + (buf * 16 + fr) * XLS + 8 * fq;
        bf16x8 xw[2], xa[2], xg[4];
#pragma unroll
        for (int s = 0; s < 2; ++s) { xw[s] = *(const LAS bf16x8*)(xrow + 32 * s); xa[s] = *(const LAS bf16x8*)(xrow + 64 + 32 * s); }
#pragma unroll
        for (int s = 0; s < 4; ++s) xg[s] = *(const LAS bf16x8*)(xrow + 128 + 32 * s);
        f32x4 r4[4], k4[4], v4[4]; float ssq = 0.f;
#pragma unroll
        for (int nb = 0; nb < 4; ++nb) { const int c = 64 * h + 16 * nb + 4 * fq;
            const f32x4 cr = ldbf4(curp + c), pr = ldbf4(prevp + c), ck = ldbf4(curp + 512 + c), pk = ldbf4(prevp + 512 + c), cv = ldbf4(curp + 1024 + c), pvv = ldbf4(prevp + 1024 + c);
            r4[nb] = cr + (pr - cr) * *(const LAS f32x4*)(PAR + 0 * 512 + c); k4[nb] = ck + (pk - ck) * *(const LAS f32x4*)(PAR + 1 * 512 + c); v4[nb] = cv + (pvv - cv) * *(const LAS f32x4*)(PAR + 2 * 512 + c);
            const f32x4 kk = k4[nb] * *(const LAS f32x4*)(PAR + 5 * 512 + c); ssq += (kk[0] * kk[0] + kk[1] * kk[1]) + (kk[2] * kk[2] + kk[3] * kk[3]); }
        ssq = xsum32(xsum16(ssq));
        const float rn = 1.0f / fmaxf(sqrtf(ssq), 1e-12f); float bon = 0.f;
        float* sip = (float*)(F.ws + WS_SI) + sioff;
#pragma unroll
        for (int nb = 0; nb < 4; ++nb) {
            const int cl = 16 * nb + 4 * fq, c = 64 * h + cl;
            f32x4 aw = {0.f, 0.f, 0.f, 0.f}, aa = aw, ag = aw;
            const bf16* wrow = (const bf16*)(F.ws + WS_LORA) + (size_t)(64 * h + 16 * nb + fr) * 64 + 8 * fq; const bf16* arow = wrow + 512 * 64; const bf16* grow = (const bf16*)(F.ws + WS_LORA) + 2 * 512 * 64 + (size_t)(64 * h + 16 * nb + fr) * 128 + 8 * fq;
#pragma unroll
            for (int s = 0; s < 2; ++s) { aw = __builtin_amdgcn_mfma_f32_16x16x32_bf16(*(const GAS bf16x8*)(wrow + 32 * s), xw[s], aw, 0, 0, 0); aa = __builtin_amdgcn_mfma_f32_16x16x32_bf16(*(const GAS bf16x8*)(arow + 32 * s), xa[s], aa, 0, 0, 0); }
#pragma unroll
            for (int s = 0; s < 4; ++s) ag = __builtin_amdgcn_mfma_f32_16x16x32_bf16(*(const GAS bf16x8*)(grow + 32 * s), xg[s], ag, 0, 0, 0);
            const f32x4 w0 = *(const LAS f32x4*)(PAR + 3 * 512 + c), a0 = *(const LAS f32x4*)(PAR + 4 * 512 + c), kkp = *(const LAS f32x4*)(PAR + 5 * 512 + c), ka = *(const LAS f32x4*)(PAR + 6 * 512 + c), rk = *(const LAS f32x4*)(PAR + 7 * 512 + c);
            f32x4 dec, a4;
#pragma unroll
            for (int i = 0; i < 4; ++i) { const float z = -(w0[i] + aw[i]);
                const float sp = fmaxf(z, 0.f) + __logf(1.f + __expf(-fabsf(z))); const float lw = -sp - 0.5f; dec[i] = __expf(-__expf(lw)); a4[i] = sigm(a0[i] + aa[i]); }
            const f32x4 kkn = (k4[nb] * kkp) * rn; const f32x4 krp = k4[nb] * (1.f + (a4 - 1.f) * ka); const f32x4 bb = kkn * a4; const f32x4 pr = r4[nb] * krp * rk;
            bon += (pr[0] + pr[1]) + (pr[2] + pr[3]);
            *(GAS f32x4*)(sip + cl) = -kkn; *(GAS f32x4*)(sip + 64 + cl) = dec; *(GAS f32x4*)(sip + 128 + cl) = bb; *(GAS f32x4*)(sip + 192 + cl) = krp; *(GAS f32x4*)(sip + 256 + cl) = r4[nb]; *(GAS f32x4*)(sip + 320 + cl) = v4[nb];
            *(GAS f32x4*)((float*)(F.ws + WS_G) + (size_t)m * 512 + c) = ag;
        }
        bon = xsum32(xsum16(bon));
        if (fq == 0) ((float*)(F.ws + WS_BONUS))[(size_t)m * RH + h] = bon;
    }
    __syncthreads();
}
__device__ __forceinline__ void scan_sample_task(Frame& F, int cs) {
    const int kp = F.lane & 31, hr = F.lane >> 5, bh = cs >> 2;
    const float* src = (const float*)(F.ws + WS_SI) + SI_S0 + (size_t)bh * DECS * 384;
    f32x2 n2[DECS], w2[DECS], b2[DECS], k2[DECS], r2[DECS];
#pragma unroll
    for (int t = 0; t < DECS; ++t) { const float* sp = src + t * 384 + 2 * kp; n2[t] = *(const GAS f32x2*)(sp); w2[t] = *(const GAS f32x2*)(sp + 64); b2[t] = *(const GAS f32x2*)(sp + 128); k2[t] = *(const GAS f32x2*)(sp + 192); r2[t] = *(const GAS f32x2*)(sp + 256); }
#pragma unroll 2
    for (int i = 0; i < 8; ++i) {
        const int vrow = 2 * ((cs & 3) * 8 + i) + hr;
        f32x2 st = *(const GAS f32x2*)(F.state_wkv + ((size_t)bh * 64 + vrow) * 64 + 2 * kp); float vv[DECS];
#pragma unroll
        for (int t = 0; t < DECS; ++t) vv[t] = src[t * 384 + 320 + vrow];
#pragma unroll
        for (int t = 0; t < DECS; ++t) {
            const float sa = red32(st.x * n2[t].x + st.y * n2[t].y);
            st.x = st.x * w2[t].x + sa * b2[t].x + vv[t] * k2[t].x; st.y = st.y * w2[t].y + sa * b2[t].y + vv[t] * k2[t].y;
            const float y = red32(st.x * r2[t].x + st.y * r2[t].y);
            if (kp == 0) ((float*)(F.ws + WS_Y))[(size_t)(MP + (bh >> 3) * DECS + t) * 512 + (bh & 7) * 64 + vrow] = y;
        }
        *(GAS f32x2*)(F.out + OUT_WS + ((size_t)bh * 64 + vrow) * 64 + 2 * kp) = st;
    }
}
template <int CTRL> __device__ __forceinline__ float xr_stage(float lo, float hi, bool bit) { const float keep = bit ? hi : lo, send = bit ? lo : hi; return keep + dpp_mov<CTRL>(send); }
__device__ __forceinline__ void transpose_reduce16(const float (&P)[32], int lane, float& ylo, float& yhi) {
    float Q[16], R[8], T[4];
    const bool b3 = (lane & 8) != 0, b2 = (lane & 4) != 0, b1 = (lane & 2) != 0, b0 = (lane & 1) != 0;
#pragma unroll
    for (int i = 0; i < 8; ++i) { Q[i] = xr_stage<0x128>(P[i], P[i + 8], b3); Q[8 + i] = xr_stage<0x128>(P[16 + i], P[24 + i], b3); }
#pragma unroll
    for (int i = 0; i < 4; ++i) { R[i] = xr_stage<0x141>(Q[i], Q[i + 4], b2); R[4 + i] = xr_stage<0x141>(Q[8 + i], Q[12 + i], b2); }
#pragma unroll
    for (int i = 0; i < 2; ++i) { T[i] = xr_stage<0x4E>(R[i], R[i + 2], b1); T[2 + i] = xr_stage<0x4E>(R[4 + i], R[6 + i], b1); }
    ylo = xr_stage<0xB1>(T[0], T[1], b0); yhi = xr_stage<0xB1>(T[2], T[3], b0);
}
__device__ __forceinline__ void scan_prompt(Frame& F) {
    constexpr int TC = 32, CH = TC * 384, NCH = SEQ / TC, PF = 2;
    LAS float* buf = (LAS float*)(F.lds + RING_OFF);
    const int lane = F.lane, kq = lane & 15, ri = lane >> 4;
    volatile LAS unsigned* sctr = F.MISC + 16; unsigned epoch = *sctr >> 2;
    for (int item = F.vcu; item < NB * RH * 4; item += F.G) {
        const int bh = item >> 2, rg = item & 3, vrow = rg * 16 + (F.wave & 3) * 4 + ri;
        const float* src = (const float*)(F.ws + WS_SI) + (size_t)bh * SEQ * 384;
        float* yout = (float*)(F.ws + WS_Y) + (size_t)((bh >> 3) * SEQ + kq) * 512 + (bh & 7) * 64 + vrow;
        float s0 = 0.f, s1 = 0.f, s2 = 0.f, s3 = 0.f; float zero_ = 0.f; asm volatile("" : "+v"(zero_));
#define SCAN_STAGE(cc, bb) do { _Pragma("unroll") for (int _p = 0; _p < 12; ++_p) { const int pc = F.wave + 4 * _p; \
            __builtin_amdgcn_global_load_lds((const unsigned*)(src + (size_t)(cc) * CH + pc * 256 + lane * 4), (LAS unsigned*)(buf + (bb) * CH + pc * 256), 16, 0, 0); } } while (0)
#define SCAN_SYNC(WAITS) do { asm volatile(WAITS ::: "memory"); ++epoch; if (lane == 0) __hip_atomic_fetch_add((LAS unsigned*)sctr, 1u, __ATOMIC_RELAXED, __HIP_MEMORY_SCOPE_WORKGROUP); \
            while (*sctr < 4u * epoch) __builtin_amdgcn_s_sleep(1); asm volatile("" ::: "memory"); } while (0)
        SCAN_STAGE(0, 0);
        SCAN_SYNC("s_waitcnt vmcnt(0) lgkmcnt(0)");
        for (int c = 0; c < NCH; ++c) {
            const int cur = c & 1;
            if (c + 1 < NCH) SCAN_STAGE(c + 1, cur ^ 1);
            {
            const LAS float* bp = buf + cur * CH;
            f32x4 nn[TC], ww[TC], bb[TC], kk[TC], rr[TC]; float vv[TC], P[TC];
#define SCAN_LD(t) do { const LAS float* np = bp + (t) * 384 + 4 * kq; nn[t] = *(const LAS f32x4*)(np); ww[t] = *(const LAS f32x4*)(np + 64); bb[t] = *(const LAS f32x4*)(np + 128); kk[t] = *(const LAS f32x4*)(np + 192); \
                rr[t] = *(const LAS f32x4*)(np + 256); vv[t] = bp[(t) * 384 + 320 + vrow]; } while (0)
#if MK_SCAN_PROBE == 1
#define SCAN_EXTRA "s_nop 1\n\tv_add_f32_dpp %[p], %[z], %[p] row_mirror row_mask:0xf bank_mask:0xf bound_ctrl:1\n\ts_nop 1\n\tv_add_f32_dpp %[p], %[z], %[p] row_mirror row_mask:0xf bank_mask:0xf bound_ctrl:1\n\ts_nop 1\n\tv_add_f32_dpp %[p], %[z], %[p] row_mirror row_mask:0xf bank_mask:0xf bound_ctrl:1\n\ts_nop 1\n\tv_add_f32_dpp %[p], %[z], %[p] row_mirror row_mask:0xf bank_mask:0xf bound_ctrl:1\n\ts_nop 1\n\t"
#elif MK_SCAN_PROBE == 2
#define SCAN_EXTRA "s_nop 1\n\tv_add_f32 %[p], %[z], %[p]\n\ts_nop 1\n\tv_add_f32 %[p], %[z], %[p]\n\ts_nop 1\n\tv_add_f32 %[p], %[z], %[p]\n\ts_nop 1\n\tv_add_f32 %[p], %[z], %[p]\n\ts_nop 1\n\t"
#else
#define SCAN_EXTRA
#endif
#define SCAN_STEP(t, RP, YP) do { float p_, a0_, a1_, a2_, a3_; \
                asm volatile("v_mul_f32 %[p], %[s0], %[n0]\n\tv_mul_f32 %[a0], %[s0], %[w0]\n\tv_fma_f32 %[p], %[s1], %[n1], %[p]\n\tv_mul_f32 %[a1], %[s1], %[w1]\n\tv_fma_f32 %[p], %[s2], %[n2], %[p]\n\tv_mul_f32 %[a2], %[s2], %[w2]\n\t" \
                    "v_fma_f32 %[p], %[s3], %[n3], %[p]\n\tv_mul_f32 %[a3], %[s3], %[w3]\n\tv_fma_f32 %[a0], %[vv], %[k0], %[a0]\n\tv_fma_f32 %[a1], %[vv], %[k1], %[a1]\n\t" \
                    "v_add_f32_dpp %[p], %[p], %[p] quad_perm:[1,0,3,2] row_mask:0xf bank_mask:0xf bound_ctrl:1\n\tv_fma_f32 %[a2], %[vv], %[k2], %[a2]\n\tv_fma_f32 %[a3], %[vv], %[k3], %[a3]\n\t" \
                    "v_add_f32_dpp %[p], %[p], %[p] quad_perm:[2,3,0,1] row_mask:0xf bank_mask:0xf bound_ctrl:1\n\tv_mul_f32 %[y], %[s0], %[r0]\n\tv_fma_f32 %[y], %[s1], %[r1], %[y]\n\t" \
                    "v_add_f32_dpp %[p], %[p], %[p] row_half_mirror row_mask:0xf bank_mask:0xf bound_ctrl:1\n\tv_fma_f32 %[y], %[s2], %[r2], %[y]\n\tv_fma_f32 %[y], %[s3], %[r3], %[y]\n\t" \
                    "v_add_f32_dpp %[p], %[p], %[p] row_mirror row_mask:0xf bank_mask:0xf bound_ctrl:1\n\ts_nop 0\n\t" SCAN_EXTRA \
                    "v_fma_f32 %[s0], %[p], %[b0], %[a0]\n\tv_fma_f32 %[s1], %[p], %[b1], %[a1]\n\tv_fma_f32 %[s2], %[p], %[b2], %[a2]\n\tv_fma_f32 %[s3], %[p], %[b3], %[a3]" \
                    : [s0] "+v"(s0), [s1] "+v"(s1), [s2] "+v"(s2), [s3] "+v"(s3), [y] "=&v"(YP), [p] "=&v"(p_), [a0] "=&v"(a0_), [a1] "=&v"(a1_), [a2] "=&v"(a2_), [a3] "=&v"(a3_) \
                    : [n0] "v"(nn[t][0]), [n1] "v"(nn[t][1]), [n2] "v"(nn[t][2]), [n3] "v"(nn[t][3]), [w0] "v"(ww[t][0]), [w1] "v"(ww[t][1]), [w2] "v"(ww[t][2]), [w3] "v"(ww[t][3]), \
                      [b0] "v"(bb[t][0]), [b1] "v"(bb[t][1]), [b2] "v"(bb[t][2]), [b3] "v"(bb[t][3]), [k0] "v"(kk[t][0]), [k1] "v"(kk[t][1]), [k2] "v"(kk[t][2]), [k3] "v"(kk[t][3]), [vv] "v"(vv[t]), \
                      [r0] "v"(RP[0]), [r1] "v"(RP[1]), [r2] "v"(RP[2]), [r3] "v"(RP[3]), [z] "v"(zero_)); } while (0)
#pragma unroll
            for (int t = 0; t < PF; ++t) SCAN_LD(t);
#pragma unroll
            for (int t = 0; t < TC; ++t) {
                if (t + PF < TC) SCAN_LD(t + PF);
                __builtin_amdgcn_sched_barrier(0);
                if (t == 0) { float dummy; SCAN_STEP(0, rr[0], dummy); (void)dummy; }
                else SCAN_STEP(t, rr[t - 1], P[t - 1]);
                __builtin_amdgcn_sched_barrier(0);
            }
            P[TC - 1] = (s0 * rr[TC - 1][0] + s1 * rr[TC - 1][1]) + (s2 * rr[TC - 1][2] + s3 * rr[TC - 1][3]);
#undef SCAN_STEP
#undef SCAN_LD
            float ylo, yhi; transpose_reduce16(P, lane, ylo, yhi);
            yout[(size_t)c * TC * 512] = ylo; yout[(size_t)(c * TC + 16) * 512] = yhi;
            }
            SCAN_SYNC("s_waitcnt vmcnt(2) lgkmcnt(0)");
        }
#undef SCAN_STAGE
#undef SCAN_SYNC
        *(GAS f32x4*)(F.out + OUT_WP + ((size_t)bh * 64 + vrow) * 64 + 4 * kq) = (f32x4){s0, s1, s2, s3};
    }
}
template <class T> __device__ __forceinline__ T ld_u(const float* ubase, unsigned byte_off) { return *(const GAS T*)((const GAS char*)ubase + byte_off); }
__device__ __forceinline__ void decode_task(Frame& F, int unit, int w) {
    const int lane = F.lane, j = lane & 15, grp = lane >> 4;
    const LAS float* lutD = (const LAS float*)(F.lds + LUTD_OFF);
    const int tq = j & 3, mp = (j >> 2) & 1, b = unit >> 2, h = unit & 3;
    bf16x8 qf[4];
#pragma unroll
    for (int s = 0; s < 4; ++s) { v4u z = {0u, 0u, 0u, 0u};
        if (j < 8 && (s >> 1) == mp) z = *(const GAS v4u*)(((bf16*)(F.ws + WS_QKV)) + (size_t)(MP + DECS * b + tq) * 1536 + (h * 2 + mp) * 64 + 32 * (s & 1) + 8 * grp);
        qf[s] = __builtin_bit_cast(bf16x8, z); }
    float mrow = -1e30f, lsum = 0.f; f32x4 o[8];
#pragma unroll
    for (int i = 0; i < 8; ++i) o[i] = (f32x4){0.f, 0.f, 0.f, 0.f};
    const int* pt = F.page_table + b * NPG;
    f32x4 kr[2][4][2]; float vr[8][8];
#define DEC_TOK0(it) ((size_t)pt[(256 * w + 32 * (it)) >> 7] * PAGE + ((256 * w + 32 * (it)) & 127))
    const unsigned koff = (unsigned)j * 2048u + (unsigned)grp * 32u, voff = (unsigned)j * 4u + (unsigned)grp * 8192u;
#define DEC_KPTRS(tok0) const char* kq0 = (const char*)(F.cache_k + ((tok0) * 4 + h) * 128) + koff; const char* kq1 = kq0 + 32768; asm volatile("" : "+v"(kq0), "+v"(kq1))
#define DEC_VPTRS(tok0) const char* vq0 = (const char*)(F.cache_v + ((tok0) * 4 + h) * 128) + voff; const char* vq1 = vq0 + 4096; const char* vq2 = vq0 + 32768; const char* vq3 = vq0 + 36864; asm volatile("" : "+v"(vq0), "+v"(vq1), "+v"(vq2), "+v"(vq3))
#define DEC_KLD(T, s, hf) (*(const GAS f32x4*)(((T) ? kq1 : kq0) + (s) * 128 + (hf) * 16))
#define DEC_VLD(blk, e) (*(const GAS float*)(((e) < 2 ? vq0 : (e) < 4 ? vq1 : (e) < 6 ? vq2 : vq3) + ((e) & 1) * 2048 + (blk) * 64))
#define DEC_LDK(tok0) do { DEC_KPTRS(tok0); _Pragma("unroll") for (int T = 0; T < 2; ++T) _Pragma("unroll") for (int s = 0; s < 4; ++s) { kr[T][s][0] = DEC_KLD(T, s, 0); kr[T][s][1] = DEC_KLD(T, s, 1); } } while (0)
#define DEC_LDV(tok0) do { DEC_VPTRS(tok0); _Pragma("unroll") for (int blk = 0; blk < 8; ++blk) _Pragma("unroll") for (int e = 0; e < 8; ++e) vr[blk][e] = DEC_VLD(blk, e); } while (0)
    { const size_t t0 = DEC_TOK0(0); DEC_LDK(t0); DEC_LDV(t0); }
#pragma unroll 1
    for (int it = 0; it < 8; ++it) {
        const int p0 = 256 * w + 32 * it; const bool more = it + 1 < 8;
        const size_t tokn = more ? DEC_TOK0(it + 1) : DEC_TOK0(it);
        f32x4 sT[2];
        DEC_KPTRS(tokn);
#pragma unroll
        for (int T = 0; T < 2; ++T) { f32x4 acc = {0.f, 0.f, 0.f, 0.f};
#pragma unroll
            for (int s = 0; s < 4; ++s) { const f32x4 a0 = kr[T][s][0], a1 = kr[T][s][1]; float e[8] = {a0[0], a0[1], a0[2], a0[3], a1[0], a1[1], a1[2], a1[3]}; const bf16x8 kb = pack8(e);
                kr[T][s][0] = DEC_KLD(T, s, 0); kr[T][s][1] = DEC_KLD(T, s, 1);
                acc = __builtin_amdgcn_mfma_f32_16x16x32_bf16(kb, qf[s], acc, 0, 0, 0); __builtin_amdgcn_sched_barrier(0); }
            sT[T] = acc; }
        if (p0 >= SEQ - 128) {
#pragma unroll
            for (int T = 0; T < 2; ++T)
#pragma unroll
                for (int r = 0; r < 4; ++r) { int n = (SEQ + tq) - (p0 + 16 * T + 4 * grp + r); n = n > 127 ? 127 : n; sT[T][r] += lutD[h * 128 + n]; } }
        float tmax = fmaxf(fmaxf(fmaxf(sT[0][0], sT[0][1]), fmaxf(sT[0][2], sT[0][3])), fmaxf(fmaxf(sT[1][0], sT[1][1]), fmaxf(sT[1][2], sT[1][3])));
        tmax = xmax32(xmax16(tmax));
        const float mnew = fmaxf(mrow, tmax), alpha = __builtin_amdgcn_exp2f(mrow - mnew); mrow = mnew;
        float p[8]; float ps = 0.f;
#pragma unroll
        for (int r = 0; r < 4; ++r) { p[r] = __builtin_amdgcn_exp2f(sT[0][r] - mnew); p[4 + r] = __builtin_amdgcn_exp2f(sT[1][r] - mnew); ps += p[r] + p[4 + r]; }
        lsum = lsum * alpha + ps;
        const bf16x8 pf = pack8(p);
        __builtin_amdgcn_sched_barrier(0);
        DEC_VPTRS(tokn);
#pragma unroll
        for (int blk = 0; blk < 8; ++blk) { const bf16x8 vb = pack8(vr[blk]);
#pragma unroll
            for (int e = 0; e < 8; ++e) vr[blk][e] = DEC_VLD(blk, e);
            o[blk] = o[blk] * alpha; o[blk] = __builtin_amdgcn_mfma_f32_16x16x32_bf16(vb, pf, o[blk], 0, 0, 0); __builtin_amdgcn_sched_barrier(0); }
    }
#undef DEC_TOK0
#undef DEC_LDK
#undef DEC_LDV
#undef DEC_KPTRS
#undef DEC_VPTRS
#undef DEC_KLD
#undef DEC_VLD
    if (w == 0) {
        const float* kp_ = F.out + OUT_KS + ((size_t)(DECS * b + (j & 3)) * 512) + h * 128 + 8 * grp; f32x4 acc = {0.f, 0.f, 0.f, 0.f};
#pragma unroll
        for (int s = 0; s < 4; ++s) { f32x4 a0 = {0.f, 0.f, 0.f, 0.f}, a1 = a0; if (j < 4) { a0 = *(const GAS f32x4*)(kp_ + 32 * s); a1 = *(const GAS f32x4*)(kp_ + 32 * s + 4); }
            float e[8] = {a0[0], a0[1], a0[2], a0[3], a1[0], a1[1], a1[2], a1[3]}; acc = __builtin_amdgcn_mfma_f32_16x16x32_bf16(pack8(e), qf[s], acc, 0, 0, 0); }
#pragma unroll
        for (int r = 0; r < 4; ++r) { const int key = 4 * grp + r; const bool ok = key < 4 && key <= tq; const int n = ok ? tq - key : 0; acc[r] = ok ? acc[r] + lutD[h * 128 + n] : -INFINITY; }
        float tmax = xmax32(xmax16(fmaxf(fmaxf(acc[0], acc[1]), fmaxf(acc[2], acc[3]))));
        const float mnew = fmaxf(mrow, tmax), alpha = __builtin_amdgcn_exp2f(mrow - mnew); mrow = mnew;
        float p[8]; float ps = 0.f;
#pragma unroll
        for (int r = 0; r < 4; ++r) { p[r] = __builtin_amdgcn_exp2f(acc[r] - mnew); p[4 + r] = 0.f; ps += p[r]; }
        lsum = lsum * alpha + ps;
        const bf16x8 pf = pack8(p);
        const float* vbase = F.out + OUT_VS + (size_t)(DECS * b) * 512 + h * 128;
#pragma unroll
        for (int blk = 0; blk < 8; ++blk) { float v8[8];
#pragma unroll
            for (int e = 0; e < 8; ++e) { const int key = 4 * grp + e; v8[e] = (e < 4 && key < 4) ? vbase[(size_t)key * 512 + 16 * blk + j] : 0.f; }
            o[blk] = o[blk] * alpha; o[blk] = __builtin_amdgcn_mfma_f32_16x16x32_bf16(pack8(v8), pf, o[blk], 0, 0, 0); }
    }
    lsum = xsum32(xsum16(lsum));
    if (j < 8) {
        float* dpo = (float*)(F.ws + WS_DPO) + ((size_t)(unit * 8 + w) * 8 + j) * 128 + 4 * grp;
#pragma unroll
        for (int blk = 0; blk < 8; ++blk) *(GAS f32x4*)(dpo + 16 * blk) = o[blk];
        if (grp == 0) { float* dpm = (float*)(F.ws + WS_DPM) + (size_t)(unit * 8 + w) * 16; dpm[j] = mrow; dpm[8 + j] = lsum; }
    }
}
__device__ __forceinline__ void prompt_attn(Frame& F, char* ldsg, int reps) {
    attn_body::lds_cfptr lut = (attn_body::lds_cfptr)(F.lds + LUTR_OFF);
    for (int i = F.vcu; i < NB * 16 * 8 * reps; i += F.G) {
        const int jj = i & 255, k = (i >> 8) & 3, bvh = jj >> 1, s = 2 * (jj & 1) + (k >> 1), qb = (k & 1) ? 7 - s : s;
        const int b = bvh >> 4, vh = bvh & 15, h = vh >> 2, mp = (vh >> 1) & 1, half = vh & 1;
        const attn_body::bf16* Q = (const attn_body::bf16*)((bf16*)(F.ws + WS_QKV)) + (h * 2 + mp) * 64; const attn_body::bf16* K = (const attn_body::bf16*)((bf16*)(F.ws + WS_QKV)) + 512 + (h * 2 + mp) * 64;
        const attn_body::bf16* V = (const attn_body::bf16*)((bf16*)(F.ws + WS_QKV)) + 1024 + h * 128 + half * 64; attn_body::bf16* O = (attn_body::bf16*)((bf16*)(F.ws + WS_O)) + vh * 64;
        attn_body::attn_unit<8>(b, qb, Q, K, V, O, lut + h * 640, ldsg + RING_OFF);
    }
}
__device__ __forceinline__ void post_phase(Frame& F, float lam) {
    const int gw = F.vcu * NWAVES + F.wave, NGW = F.G * NWAVES, lane = F.lane, c0 = 8 * lane, hh = lane >> 3;
    f32x4 gnw[2], gnb[2];
    gnw[0] = *(const GAS f32x4*)(F.gn_w + c0); gnw[1] = *(const GAS f32x4*)(F.gn_w + c0 + 4); gnb[0] = *(const GAS f32x4*)(F.gn_b + c0); gnb[1] = *(const GAS f32x4*)(F.gn_b + c0 + 4);
    const int ah = lane >> 4, ahalf = (lane >> 3) & 1, ad = 8 * (lane & 7);
    f32x4 sl[2]; sl[0] = *(const GAS f32x4*)(F.subln + (c0 & 127)); sl[1] = *(const GAS f32x4*)(F.subln + (c0 & 127) + 4);
    for (int m = gw; m < M; m += NGW) {
        size_t sioff;
        if (m < MP) sioff = ((size_t)((m >> 11) * RH + hh) * SEQ + (m & (SEQ - 1))) * 384; else { const int ms = m - MP; sioff = SI_S0 + ((size_t)((ms >> 2) * RH + hh) * DECS + (ms & 3)) * 384; }
        const float* yp = ((float*)(F.ws + WS_Y)) + (size_t)m * 512 + c0; const float* vp = ((float*)(F.ws + WS_SI)) + sioff + 5 * 64 + (c0 & 63); const float* gp = ((float*)(F.ws + WS_G)) + (size_t)m * 512 + c0;
        f32x4 y[2], vr[2], g[2]; y[0] = *(const GAS f32x4*)yp; y[1] = *(const GAS f32x4*)(yp + 4); vr[0] = *(const GAS f32x4*)vp; vr[1] = *(const GAS f32x4*)(vp + 4); g[0] = *(const GAS f32x4*)gp; g[1] = *(const GAS f32x4*)(gp + 4);
        const float bon = ((float*)(F.ws + WS_BONUS))[(size_t)m * RH + hh];
        const float mean = red8((y[0][0] + y[0][1]) + (y[0][2] + y[0][3]) + (y[1][0] + y[1][1]) + (y[1][2] + y[1][3])) * (1.f / 64.f);
        const f32x4 d0 = y[0] - mean, d1 = y[1] - mean;
        const float var = red8((d0[0] * d0[0] + d0[1] * d0[1]) + (d0[2] * d0[2] + d0[3] * d0[3]) + (d1[0] * d1[0] + d1[1] * d1[1]) + (d1[2] * d1[2] + d1[3] * d1[3])) * (1.f / 64.f);
        const float rstd = 1.0f / sqrtf(var + GN_EPS);
        const f32x4 o0 = (d0 * rstd * gnw[0] + gnb[0] + vr[0] * bon) * g[0], o1 = (d1 * rstd * gnw[1] + gnb[1] + vr[1] * bon) * g[1];
        v4u w; w.x = pk2(o0[0], o0[1]); w.y = pk2(o0[2], o0[3]); w.z = pk2(o1[0], o1[1]); w.w = pk2(o1[2], o1[3]);
        *(GAS v4u*)(((bf16*)(F.ws + WS_XM)) + (size_t)m * DM + c0) = w;
        if (m >= MP) {
            const int ms = m - MP, bq = ms >> 2, t4 = ms & 3, unit = bq * 4 + ah, dv0 = 8 * (lane & 15); float res[2][8];
#pragma unroll
            for (int q = 0; q < 2; ++q) { const int row = 4 * q + t4; const float* dpm = (const float*)(F.ws + WS_DPM) + (size_t)unit * 128; float ms_[8], mx = -1e30f;
#pragma unroll
                for (int s = 0; s < 8; ++s) { ms_[s] = dpm[s * 16 + row]; mx = fmaxf(mx, ms_[s]); }
                float L = 0.f; f32x4 a0 = {0.f, 0.f, 0.f, 0.f}, a1 = a0;
#pragma unroll
                for (int s = 0; s < 8; ++s) { const float sc = __builtin_amdgcn_exp2f(ms_[s] - mx); L += dpm[s * 16 + 8 + row] * sc; const float* po = (const float*)(F.ws + WS_DPO) + ((size_t)(unit * 8 + s) * 8 + row) * 128 + dv0;
                    a0 += *(const GAS f32x4*)po * sc; a1 += *(const GAS f32x4*)(po + 4) * sc; }
                const float il = 1.0f / L;
#pragma unroll
                for (int i = 0; i < 4; ++i) { res[q][i] = a0[i] * il; res[q][4 + i] = a1[i] * il; } }
            float d[8], ss = 0.f;
#pragma unroll
            for (int i = 0; i < 8; ++i) { d[i] = res[0][i] - lam * res[1][i]; ss += d[i] * d[i]; }
            const float rs = (1.f - LAM_INIT) / sqrtf(red16(ss) * (1.f / 128.f) + SUBLN_EPS);
            v4u q; q.x = pk2(d[0] * rs * sl[0][0], d[1] * rs * sl[0][1]); q.y = pk2(d[2] * rs * sl[0][2], d[3] * rs * sl[0][3]); q.z = pk2(d[4] * rs * sl[1][0], d[5] * rs * sl[1][1]); q.w = pk2(d[6] * rs * sl[1][2], d[7] * rs * sl[1][3]);
            *(GAS v4u*)(((bf16*)(F.ws + WS_XM)) + (size_t)m * DM + 512 + c0) = q;
        } else {
            const v4u a = *(const GAS v4u*)(((bf16*)(F.ws + WS_O)) + (size_t)m * 1024 + 64 * (4 * ah + ahalf) + ad), bq = *(const GAS v4u*)(((bf16*)(F.ws + WS_O)) + (size_t)m * 1024 + 64 * (4 * ah + 2 + ahalf) + ad);
            float d[8]; const unsigned aa[4] = {a.x, a.y, a.z, a.w}, bb[4] = {bq.x, bq.y, bq.z, bq.w}; float ss = 0.f;
#pragma unroll
            for (int i = 0; i < 4; ++i) { const float a_lo = __uint_as_float(aa[i] << 16), a_hi = __uint_as_float(aa[i] & 0xffff0000u), b_lo = __uint_as_float(bb[i] << 16), b_hi = __uint_as_float(bb[i] & 0xffff0000u);
                d[2 * i] = a_lo - lam * b_lo; d[2 * i + 1] = a_hi - lam * b_hi; ss += d[2 * i] * d[2 * i] + d[2 * i + 1] * d[2 * i + 1]; }
            const float rs = (1.f - LAM_INIT) / sqrtf(red16(ss) * (1.f / 128.f) + SUBLN_EPS);
            v4u q; q.x = pk2(d[0] * rs * sl[0][0], d[1] * rs * sl[0][1]); q.y = pk2(d[2] * rs * sl[0][2], d[3] * rs * sl[0][3]); q.z = pk2(d[4] * rs * sl[1][0], d[5] * rs * sl[1][1]); q.w = pk2(d[6] * rs * sl[1][2], d[7] * rs * sl[1][3]);
            *(GAS v4u*)(((bf16*)(F.ws + WS_XM)) + (size_t)m * DM + 512 + c0) = q;
        }
    }
}
struct Args { const void* in[31]; float* out; unsigned char* ws; int ph_lo, ph_hi; };
__global__ void __launch_bounds__(NWAVES * 64, 2) mk_fwd(Args args) {
    extern __shared__ __attribute__((aligned(16))) unsigned char lds[];
    Frame F;
    F.lds = (LAS unsigned char*)lds; F.MISC = (volatile LAS unsigned*)(F.lds + MISC_OFF);
    F.tid = threadIdx.x; F.lane = F.tid & 63; F.wave = __builtin_amdgcn_readfirstlane(F.tid >> 6);
    F.G = gridDim.x; { const int bx = blockIdx.x; F.vcu = (F.G % 8 == 0) ? (bx % 8) * (F.G / 8) + bx / 8 : bx; }
    unsigned char* ws = args.ws;
    F.ctl = (gu32*)(ws + WS_CTL);
    F.x_p = (const float*)args.in[0]; F.x_s = (const float*)args.in[1]; F.cache_k = (const float*)args.in[2]; F.cache_v = (const float*)args.in[3]; F.page_table = (const int*)args.in[4];
    F.state_wkv = (const float*)args.in[5]; F.state_shift = (const float*)args.in[6]; F.gains = (const float*)args.in[7]; F.ff1_in = (const float*)args.in[8]; F.ff1_out = (const float*)args.in[9];
    F.ff2_in = (const float*)args.in[10]; F.ff2_out = (const float*)args.in[11]; F.w_in = (const float*)args.in[12]; F.w_out = (const float*)args.in[13]; F.rel_tab = (const float*)args.in[14];
    F.lq1 = (const float*)args.in[15]; F.lk1 = (const float*)args.in[16]; F.lq2 = (const float*)args.in[17]; F.lk2 = (const float*)args.in[18]; F.subln = (const float*)args.in[19];
    F.mu = (const float*)args.in[20]; F.w0 = (const float*)args.in[21]; F.w2 = (const float*)args.in[22]; F.a0 = (const float*)args.in[23]; F.a2 = (const float*)args.in[24]; F.g2 = (const float*)args.in[25];
    F.kkp = (const float*)args.in[26]; F.ka = (const float*)args.in[27]; F.rk = (const float*)args.in[28]; F.gn_w = (const float*)args.in[29]; F.gn_b = (const float*)args.in[30];
    F.out = args.out;
    F.ws = ws;
    for (int u = F.tid; u < (MISC_OFF + 128 - LDSCTL_OFF) / 4; u += NWAVES * 64) ((LAS unsigned*)(F.lds + LDSCTL_OFF))[u] = 0u;
    __syncthreads();
    XcdBarrier bar; bar.bar = (unsigned*)(F.ctl + CW_BAR); bar.x = 0; bar.st = nullptr;
    if (!MK_PER_PHASE) bar = xcd_barrier_post((unsigned*)(F.ctl + CW_BAR), F.MISC + 8);
#ifndef MK_BAR_REPS
#define MK_BAR_REPS 1
#endif
#define GRID_BAR() do { if (!MK_PER_PHASE) { for (int br_ = 0; br_ < MK_BAR_REPS; ++br_) xcd_barrier(bar); } } while (0)
    const int lo = args.ph_lo, hi = args.ph_hi;
#ifndef MK_PHASE_MASK
#define MK_PHASE_MASK 0x1fff
#endif
#define IN(k) (((MK_PHASE_MASK >> (k)) & 1) && lo <= (k) && (k) < hi)
#define BOTH(k) (IN(k) && IN((k) + 1))
#ifndef MK_DUP_PH
#define MK_DUP_PH 0
#endif
#define REPS(k) ((((MK_DUP_PH) >> (k)) & 1) ? 2 : 1)
    const float* g = F.gains;
    if (IN(0)) { for (int rep = 0; rep < REPS(0); ++rep) p0_prologue(F); if (BOTH(0)) GRID_BAR(); }
    if (IN(1)) { pg8::Gemm gm{((bf16*)(F.ws + WS_XN)), ((bf16*)(F.ws + WS_FF1IN)), M, 2 * DFF, DM}; pg8::StaticOrder S; S.init(M, 2 * DFF, F.G, (int)blockIdx.x, DM); pg8::EpiSwiGLU E{((bf16*)(F.ws + WS_H)), DFF};
        pg8::gemm_phase<pg8::EpiSwiGLU, pg8::StaticOrder, true, true>(F.lds + RING_OFF, gm, S, E); if (REPS(1) == 2) pg8::gemm_phase<pg8::EpiSwiGLU, pg8::StaticOrder, true, true>(F.lds + RING_OFF, gm, S, E); if (BOTH(1)) GRID_BAR(); }
    if (IN(2)) { pg8::Gemm gm{((bf16*)(F.ws + WS_H)), ((bf16*)(F.ws + WS_FF1OUT)), M, DM, DFF}; pg8::TailSplitOrder S; S.init(MP, MS, DM, F.G, (int)blockIdx.x, DFF); pg8::EpiF32 E{(bf16*)(F.ws + WS_F), DM, (float*)(F.ws + WS_SLAB), MP, MS, DFF / 64};
        for (int rep = 0; rep < REPS(2); ++rep) pg8::gemm_phase<pg8::EpiF32, pg8::TailSplitOrder, true, true>(F.lds + RING_OFF, gm, S, E); if (BOTH(2)) GRID_BAR(); }
    if (IN(3)) { for (int rep = 0; rep < REPS(3); ++rep) rowwise_phase<true, DFF / 256>(F, F.x_p, F.x_s, ((float*)(F.ws + WS_HRES)), g + 1 * DM, 0.5f, g + 2 * DM); if (BOTH(3)) GRID_BAR(); }
    if (IN(4)) { pg8::Gemm gm{((bf16*)(F.ws + WS_XN)), ((bf16*)(F.ws + WS_WIN)), M, PCOLS, DM}; pg8::StaticOrder S; S.init(M, PCOLS, F.G, (int)blockIdx.x, DM);
        pg8::EpiWin E{((bf16*)(F.ws + WS_QKV)), ((bf16*)(F.ws + WS_PR)), F.out + OUT_KP, F.out + OUT_VP, F.out + OUT_KS, F.out + OUT_VS, F.out + OUT_SP, F.out + OUT_SS, QSCALE, MP, SEQ};
        for (int rep = 0; rep < REPS(4); ++rep) pg8::gemm_phase<pg8::EpiWin, pg8::StaticOrder, true, true>(F.lds + RING_OFF, gm, S, E); if (BOTH(4)) GRID_BAR(); }
#ifndef MK_DUP_P5
#define MK_DUP_P5 0
#endif
    if (IN(5)) { prep_phase(F); if (MK_DUP_P5) prep_phase(F); if (BOTH(5)) GRID_BAR(); }
    if (IN(6)) {
        LAS float* lutR = (LAS float*)(F.lds + LUTR_OFF); LAS float* lutD = (LAS float*)(F.lds + LUTD_OFF);
        for (int i = F.tid; i < 4 * 640; i += NWAVES * 64) { const int h = i / 640, j = i % 640, n = 383 - j; lutR[i] = n < 0 ? -INFINITY : bias_delta(F.rel_tab, n, h); }
        for (int i = F.tid; i < 4 * 128; i += NWAVES * 64) lutD[i] = bias_delta(F.rel_tab, i & 127, i >> 7);
        __syncthreads();
#ifndef MK_DUP_P6
#define MK_DUP_P6 0
#endif
#ifndef MK_P6_OFF
#define MK_P6_OFF 0
#endif
        volatile LAS unsigned* tctr = F.MISC + 24;
        for (int rep = 0; rep < ((MK_DUP_P6 & 2) ? 2 : 1); ++rep) { if (F.wave < 4 && !(MK_P6_OFF & 1)) scan_prompt(F); }
        constexpr int DT = DECB * 4 * 8, ST = DECB * RH * 4;
        for (;;) {
            unsigned lt = 0; if (F.lane == 0) lt = __hip_atomic_fetch_add((LAS unsigned*)tctr, 1u, __ATOMIC_RELAXED, __HIP_MEMORY_SCOPE_WORKGROUP);
            lt = (unsigned)__builtin_amdgcn_readfirstlane((int)lt);
            const int per = (DT + F.G - 1) / F.G;
            constexpr int DREP = (MK_DUP_P6 & 8) ? 2 : 1;
            if ((int)lt < per * DREP) { const int gt = F.vcu * per + (int)lt % per; if (gt < DT) decode_task(F, gt >> 3, gt & 7); continue; }
            const int ls = (int)lt - per * DREP, pers = (ST + F.G - 1) / F.G;
            if (ls < pers) { const int gs = F.vcu * pers + ls; if (gs < ST) scan_sample_task(F, gs); continue; }
            break;
        }
        __syncthreads();
        if (!(MK_P6_OFF & 2)) prompt_attn(F, (char*)lds, (MK_DUP_P6 & 4) ? 2 : 1);
        if (BOTH(6)) GRID_BAR(); }
    if (IN(7)) { const float lam = compute_lam(F); for (int rep = 0; rep < REPS(7); ++rep) post_phase(F, lam); if (BOTH(7)) GRID_BAR(); }
    if (IN(8)) { pg8::Gemm gm{((bf16*)(F.ws + WS_XM)), ((bf16*)(F.ws + WS_WOUT)), M, DM, DM}; pg8::TailSplitOrder S; S.init(MP, MS, DM, F.G, (int)blockIdx.x, DM); pg8::EpiF32 E{(bf16*)(F.ws + WS_F), DM, (float*)(F.ws + WS_SLAB), MP, MS, DM / 64};
        for (int rep = 0; rep < REPS(8); ++rep) pg8::gemm_phase<pg8::EpiF32, pg8::TailSplitOrder, true, true>(F.lds + RING_OFF, gm, S, E); if (BOTH(8)) GRID_BAR(); }
    if (IN(9)) { rowwise_phase<true, DM / 256>(F, ((float*)(F.ws + WS_HRES)), ((float*)(F.ws + WS_HRES)) + (size_t)MP * DM, ((float*)(F.ws + WS_HRES)), g + 3 * DM, 1.0f, g + 4 * DM); if (BOTH(9)) GRID_BAR(); }
    if (IN(10)) { pg8::Gemm gm{((bf16*)(F.ws + WS_XN)), ((bf16*)(F.ws + WS_FF2IN)), M, 2 * DFF, DM}; pg8::StaticOrder S; S.init(M, 2 * DFF, F.G, (int)blockIdx.x, DM); pg8::EpiSwiGLU E{((bf16*)(F.ws + WS_H)), DFF};
        for (int rep = 0; rep < REPS(10); ++rep) pg8::gemm_phase<pg8::EpiSwiGLU, pg8::StaticOrder, true, true>(F.lds + RING_OFF, gm, S, E); if (BOTH(10)) GRID_BAR(); }
    if (IN(11)) { pg8::Gemm gm{((bf16*)(F.ws + WS_H)), ((bf16*)(F.ws + WS_FF2OUT)), M, DM, DFF}; pg8::TailSplitOrder S; S.init(MP, MS, DM, F.G, (int)blockIdx.x, DFF); pg8::EpiF32 E{(bf16*)(F.ws + WS_F), DM, (float*)(F.ws + WS_SLAB), MP, MS, DFF / 64};
        for (int rep = 0; rep < REPS(11); ++rep) pg8::gemm_phase<pg8::EpiF32, pg8::TailSplitOrder, true, true>(F.lds + RING_OFF, gm, S, E); if (BOTH(11)) GRID_BAR(); }
    if (IN(12)) { for (int rep = 0; rep < REPS(12); ++rep) rowwise_phase<false, DFF / 256>(F, ((float*)(F.ws + WS_HRES)), ((float*)(F.ws + WS_HRES)) + (size_t)MP * DM, F.out + OUT_Y, g + 5 * DM, 0.5f, g + 5 * DM); }
#undef IN
#undef BOTH
#undef GRID_BAR
}

extern "C" void kernel_launch(void* const* d_in, const int* in_sizes, int n_in, void* d_out, int out_size, void* d_ws, size_t ws_size, hipStream_t stream) {
    static int grid = 0;
    if (grid == 0) {
        if (n_in != 31 || (size_t)out_size != OUT_END || ws_size < WS_END) { fprintf(stderr, "kernel_launch: unexpected shapes: n_in %d out %d ws %zu\n", n_in, out_size, ws_size); grid = -1; return; }
        int dev = 0, cus = 0, per_cu = 0;
        if (hipGetDevice(&dev) != hipSuccess || hipDeviceGetAttribute(&cus, hipDeviceAttributeMultiprocessorCount, dev) != hipSuccess) { grid = -1; return; }
        if (hipFuncSetAttribute((const void*)mk_fwd, hipFuncAttributeMaxDynamicSharedMemorySize, LDS_BYTES) != hipSuccess) { fprintf(stderr, "kernel_launch: hipFuncSetAttribute failed\n"); grid = -1; return; }
        if (hipOccupancyMaxActiveBlocksPerMultiprocessor(&per_cu, (const void*)mk_fwd, NWAVES * 64, LDS_BYTES) != hipSuccess || per_cu < 1) fprintf(stderr, "kernel_launch: occupancy query reports %d\n", per_cu);
        (void)hipGetLastError();
        grid = cus;
    }
    if (grid < 0) return;
    if (hipMemsetAsync((char*)d_ws + WS_CTL, 0, CTL_ZERO_BYTES, stream) != hipSuccess) return;
    Args a{};
    for (int i = 0; i < 31; ++i) a.in[i] = d_in[i];
    a.out = (float*)d_out; a.ws = (unsigned char*)d_ws;
#if MK_PER_PHASE
    for (int p = 0; p < NPHASE; ++p) { a.ph_lo = p; a.ph_hi = p + 1; hipLaunchKernelGGL(mk_fwd, dim3(grid), dim3(NWAVES * 64), LDS_BYTES, stream, a); }
#else
    a.ph_lo = 0; a.ph_hi = NPHASE; hipLaunchKernelGGL(mk_fwd, dim3(grid), dim3(NWAVES * 64), LDS_BYTES, stream, a);
#endif
}
```
